# Optimizing an MI355X kernel written in HIP

```python
import jax, jax.numpy as jnp
from jax import lax
import numpy as np

D_MODEL = 1024
BATCH = 8
SEQ = 2048
DEPTH = 2

N_MIXERS = 4
GROUP_W = D_MODEL // N_MIXERS
HEAD_DIM = 64
N_HEADS = GROUP_W // HEAD_DIM
D_FF = 2816
FFN_RESID = 0.5
SC_WIDTH = 3
CHUNK = 128
CM_WIDTH = 31
RANK_W = 32
RANK_A = 32
RANK_G = 64
A_COLS = 3 * GROUP_W
B_COLS = 2 * GROUP_W
C_COLS = 3 * GROUP_W + RANK_W + RANK_A + RANK_G
D_COLS = 2 * GROUP_W
IN_COLS = A_COLS + B_COLS + C_COLS + D_COLS
RMS_EPS = 1e-6
LN_EPS = 1e-5
GN_EPS = 1e-5 * HEAD_DIM

kernel_name = "hybrid_headgroup_conv_gmlp_rwkv7_conformer"


def rms_norm(x, g):
    xf = x.astype(jnp.float32)
    y = xf * lax.rsqrt(jnp.mean(xf * xf, axis=-1, keepdims=True) + RMS_EPS)
    return (y * g.astype(jnp.float32)).astype(x.dtype)


def layer_norm(x, g, b, eps=LN_EPS):
    xf = x.astype(jnp.float32)
    mu = jnp.mean(xf, axis=-1, keepdims=True)
    var = jnp.mean(jnp.square(xf - mu), axis=-1, keepdims=True)
    y = (xf - mu) * lax.rsqrt(var + eps) * g.astype(jnp.float32) + b.astype(jnp.float32)
    return y.astype(x.dtype)


def swiglu(h, w_gate, w_up, w_down):
    return (jax.nn.silu(h @ w_gate) * (h @ w_up)) @ w_down


def token_shift(t):
    return jnp.pad(t, ((0, 0), (1, 0), (0, 0)))[:, :-1, :]


def causal_depthwise_conv(x, w):
    K, C = w.shape
    return lax.conv_general_dilated(
        x, w[:, None, :].astype(x.dtype), window_strides=(1,), padding=[(K - 1, 0)],
        dimension_numbers=("NWC", "WIO", "NWC"), feature_group_count=C)


def spatial_gating(u, v, w_s, b_s, ln_w, ln_b):
    Bsz, S, G = v.shape
    v = layer_norm(v, ln_w, ln_b)
    v = v.reshape(Bsz, S // CHUNK, CHUNK, N_HEADS, G // N_HEADS)
    w = w_s * jnp.tril(jnp.ones((CHUNK, CHUNK), w_s.dtype))
    s = jnp.einsum("hts,bnshd->bnthd", w, v) + b_s.T[None, None, :, :, None]
    return u * s.reshape(Bsz, S, G)


def rwkv7_recurrence(r, w, k, v, a, b):
    Bsz, S, H, N = r.shape
    seq = tuple(jnp.swapaxes(t.astype(jnp.float32), 0, 1) for t in (r, w, k, v, a, b))

    def step(state, inp):
        r_t, w_t, k_t, v_t, a_t, b_t = inp
        sa = jnp.einsum("bhij,bhj->bhi", state, a_t)
        state = (state * w_t[:, :, None, :] + sa[..., None] * b_t[:, :, None, :]
                 + v_t[..., None] * k_t[:, :, None, :])
        y = jnp.einsum("bhij,bhj->bhi", state, r_t)
        return state, y

    s0 = jnp.zeros((Bsz, H, N, N), jnp.float32)
    _, ys = lax.scan(step, s0, seq)
    return jnp.swapaxes(ys, 0, 1)


def rwkv7_time_mix(pc, mu, w0, w_up, a0, a_up, g_up, k_k, k_a, r_k, ln_w, ln_b):
    Bsz, S, _ = pc.shape
    pc = pc + (token_shift(pc) - pc) * mu
    G = GROUP_W
    r, k, v, wd, ad, gd = jnp.split(
        pc, [G, 2 * G, 3 * G, 3 * G + RANK_W, 3 * G + RANK_W + RANK_A], axis=-1)
    w_log = -jax.nn.softplus(-(w0 + jnp.tanh(wd) @ w_up)) - 0.5
    decay = jnp.exp(-jnp.exp(w_log.astype(jnp.float32)))
    a = jax.nn.sigmoid(a0 + ad @ a_up)
    g = jax.nn.sigmoid(gd) @ g_up
    heads = lambda t: t.reshape(Bsz, S, N_HEADS, HEAD_DIM)
    kk = heads(k * k_k).astype(jnp.float32)
    kk = kk / jnp.maximum(jnp.sqrt(jnp.sum(kk * kk, axis=-1, keepdims=True)), 1e-12)
    k = k * (1.0 + (a - 1.0) * k_a)
    rh, kh, vh, ah = heads(r), heads(k), heads(v), heads(a)
    o = rwkv7_recurrence(rh, heads(decay), kh, vh, -kk, kk * ah).astype(pc.dtype)
    o = layer_norm(o, ln_w.reshape(N_HEADS, HEAD_DIM), ln_b.reshape(N_HEADS, HEAD_DIM), eps=GN_EPS)
    o = o + jnp.sum(rh * kh * r_k, axis=-1, keepdims=True) * vh
    return o.reshape(Bsz, S, G) * g


def hybrid_mix(h, w_in, sc_conv_w, sg_ln_w, sg_ln_b, sg_w, sg_b,
               rk_mu, rk_w0, rk_w_up, rk_a0, rk_a_up, rk_g_up, rk_k_k, rk_k_a, rk_r_k,
               rk_ln_w, rk_ln_b, cm_conv_w, cm_conv_b, cm_ln_w, cm_ln_b, w_out):
    p = h @ w_in
    pa, pb, pc, pd = jnp.split(p, [A_COLS, A_COLS + B_COLS, A_COLS + B_COLS + C_COLS], axis=-1)
    gate_b, gate_c, xa = jnp.split(pa, 3, axis=-1)
    y_a = gate_b * causal_depthwise_conv(gate_c * xa, sc_conv_w)
    u, v = jnp.split(pb, 2, axis=-1)
    y_b = spatial_gating(u, v, sg_w, sg_b, sg_ln_w, sg_ln_b)
    y_c = rwkv7_time_mix(pc, rk_mu, rk_w0, rk_w_up, rk_a0, rk_a_up, rk_g_up,
                         rk_k_k, rk_k_a, rk_r_k, rk_ln_w, rk_ln_b)
    z1, z2 = jnp.split(pd, 2, axis=-1)
    zd = causal_depthwise_conv(z1 * jax.nn.sigmoid(z2), cm_conv_w) + cm_conv_b
    y_d = jax.nn.silu(layer_norm(zd, cm_ln_w, cm_ln_b))
    return jnp.concatenate([y_a, y_b, y_c, y_d], axis=-1) @ w_out


def setup_inputs(seed: int = 0) -> dict:
    key = jax.random.key(seed)
    ks = iter(jax.random.split(key, 48))
    nrm = lambda shape, scale: jax.random.normal(next(ks), shape, jnp.float32) * scale
    gain = lambda shape: 1.0 + 0.02 * jax.random.normal(next(ks), shape, jnp.float32)
    L, D, F, G = DEPTH, D_MODEL, D_FF, GROUP_W
    return {
        "x": nrm((BATCH, SEQ, D), 1.0),
        "ffn1_pre_g": gain((L, D)),
        "ffn1_w_gate": nrm((L, D, F), D ** -0.5),
        "ffn1_w_up": nrm((L, D, F), D ** -0.5),
        "ffn1_w_down": nrm((L, F, D), F ** -0.5),
        "ffn1_post_g": gain((L, D)),
        "mix_pre_g": gain((L, D)),
        "w_in": nrm((L, D, IN_COLS), D ** -0.5),
        "sc_conv_w": nrm((L, SC_WIDTH, G), SC_WIDTH ** -0.5),
        "sg_ln_w": gain((L, G)),
        "sg_ln_b": nrm((L, G), 0.02),
        "sg_w": nrm((L, N_HEADS, CHUNK, CHUNK), 0.5 * CHUNK ** -0.5),
        "sg_b": gain((L, N_HEADS, CHUNK)) + nrm((L, N_HEADS, CHUNK), 0.1),
        "rk_mu": jax.random.uniform(next(ks), (L, C_COLS), jnp.float32, 0.0, 1.0),
        "rk_w0": jax.random.uniform(next(ks), (L, G), jnp.float32, -6.0, 1.0),
        "rk_w_up": nrm((L, RANK_W, G), 0.1 * RANK_W ** -0.5),
        "rk_a0": nrm((L, G), 0.1),
        "rk_a_up": nrm((L, RANK_A, G), 0.1 * RANK_A ** -0.5),
        "rk_g_up": nrm((L, RANK_G, G), RANK_G ** -0.5),
        "rk_k_k": 0.85 + nrm((L, G), 0.02),
        "rk_k_a": gain((L, G)),
        "rk_r_k": nrm((L, N_HEADS, HEAD_DIM), 0.1),
        "rk_ln_w": gain((L, G)),
        "rk_ln_b": nrm((L, G), 0.02),
        "cm_conv_w": nrm((L, CM_WIDTH, G), CM_WIDTH ** -0.5),
        "cm_conv_b": nrm((L, G), 0.02),
        "cm_ln_w": gain((L, G)),
        "cm_ln_b": nrm((L, G), 0.02),
        "w_out": nrm((L, D, D), D ** -0.5),
        "mix_post_g": gain((L, D)),
        "ffn2_pre_g": gain((L, D)),
        "ffn2_w_gate": nrm((L, D, F), D ** -0.5),
        "ffn2_w_up": nrm((L, D, F), D ** -0.5),
        "ffn2_w_down": nrm((L, F, D), F ** -0.5),
        "ffn2_post_g": gain((L, D)),
    }


def reference(x, ffn1_pre_g, ffn1_w_gate, ffn1_w_up, ffn1_w_down, ffn1_post_g,
              mix_pre_g, w_in, sc_conv_w, sg_ln_w, sg_ln_b, sg_w, sg_b,
              rk_mu, rk_w0, rk_w_up, rk_a0, rk_a_up, rk_g_up, rk_k_k, rk_k_a, rk_r_k,
              rk_ln_w, rk_ln_b, cm_conv_w, cm_conv_b, cm_ln_w, cm_ln_b, w_out, mix_post_g,
              ffn2_pre_g, ffn2_w_gate, ffn2_w_up, ffn2_w_down, ffn2_post_g):
    for l in range(DEPTH):
        h = rms_norm(x, ffn1_pre_g[l])
        x = x + FFN_RESID * rms_norm(
            swiglu(h, ffn1_w_gate[l], ffn1_w_up[l], ffn1_w_down[l]), ffn1_post_g[l])
        h = rms_norm(x, mix_pre_g[l])
        m = hybrid_mix(h, w_in[l], sc_conv_w[l], sg_ln_w[l], sg_ln_b[l], sg_w[l], sg_b[l],
                       rk_mu[l], rk_w0[l], rk_w_up[l], rk_a0[l], rk_a_up[l], rk_g_up[l],
                       rk_k_k[l], rk_k_a[l], rk_r_k[l], rk_ln_w[l], rk_ln_b[l],
                       cm_conv_w[l], cm_conv_b[l], cm_ln_w[l], cm_ln_b[l], w_out[l])
        x = x + rms_norm(m, mix_post_g[l])
        h = rms_norm(x, ffn2_pre_g[l])
        x = x + FFN_RESID * rms_norm(
            swiglu(h, ffn2_w_gate[l], ffn2_w_up[l], ffn2_w_down[l]), ffn2_post_g[l])
    return x
```

```cpp
#include <hip/hip_runtime.h>
#include <cstdio>
#include <cstdint>

#ifndef DBG_NO_PREP
#define DBG_NO_PREP 0
#endif
#ifndef DBG_NO_D
#define DBG_NO_D 0
#endif
#ifndef DBG_NO_B
#define DBG_NO_B 0
#endif
#ifndef DBG_NO_SCAN
#define DBG_NO_SCAN 0
#endif
#ifndef DBG_NO_GEMM
#define DBG_NO_GEMM 0
#endif
#ifndef MK_ONE_LAUNCH
#define MK_ONE_LAUNCH 1
#endif

namespace pg8 {
#define PG8_LAS __attribute__((address_space(3)))
typedef unsigned short bf16_t;
typedef short bf16x8 __attribute__((ext_vector_type(8)));
typedef float f32x4 __attribute__((ext_vector_type(4)));
typedef unsigned u32x4 __attribute__((ext_vector_type(4)));
constexpr int BM = 256, BK = 64, HALF = 128, HTB = HALF * BK * 2, STAGE_BYTES = 8 * HTB, NXCD = 8, WGM = 8;

__host__ __device__ __forceinline__ int lds_byte(int r, int c) { const int st = (r >> 4) * 2 + (c >> 5), rr = r & 15, cc = c & 31, ob = rr * 64 + cc * 2; return st * 1024 + (ob ^ (((ob >> 9) & 1) << 5)); }
__host__ __device__ __forceinline__ void stage_rc(int b, int& R, int& C) { const int st = b / 1024, sb = b % 1024, swz = sb ^ (((sb >> 9) & 1) << 5); R = (st >> 1) * 16 + swz / 64; C = (st & 1) * 32 + (swz % 64) / 2; }
__host__ __device__ __forceinline__ int perm32(int rho) { const int n = rho >> 4, i = rho & 15; return 8 * (i >> 2) + 4 * n + (i & 3); }

struct Unit { int pm, pn; };
struct Gemm { const bf16_t* A; const bf16_t* Bt; int M, N, K; };

struct StaticOrder {
    int nM, nN, nwg, G, c;
    __host__ __device__ void init(int M, int N, int G_, int c_) { nM = M / BM; nN = N / BM; nwg = nM * nN; G = G_; c = c_; }
    __host__ __device__ bool next(int i, Unit& u) const {
        const long L = (long)i * G + c; if (L >= nwg) return false;
        int wgid = (int)L; { const int q = nwg / NXCD, r = nwg % NXCD, xcd = wgid % NXCD, off = wgid / NXCD; wgid = (xcd < r ? xcd * (q + 1) : r * (q + 1) + (xcd - r) * q) + off; }
        const int nig = WGM * nN, gid = wgid / nig, fm = gid * WGM, gsz = (nM - fm) < WGM ? (nM - fm) : WGM;
        u.pm = fm + ((wgid % nig) % gsz); u.pn = (wgid % nig) / gsz; return true;
    }
    __device__ __forceinline__ void a_ready(const Unit&) const {}
    __device__ __forceinline__ void done(const Unit&) const {}
};

__device__ __forceinline__ unsigned cvt_pk_bf16(float lo, float hi) { unsigned r; asm volatile("v_cvt_pk_bf16_f32 %0, %1, %2" : "=v"(r) : "v"(lo), "v"(hi)); return r; }

struct EpiBf16 {
    static constexpr bool PERM = true, AFTER_DRAIN = false;
    bf16_t* O; int ldc;
    __device__ __forceinline__ void operator()(const f32x4 (&acc)[2][2][4][2], const Unit& u, int wr, int wc, int fr, int fq) const {
        const int row0 = u.pm * BM + wr * 64 + fr; const int col0 = u.pn * BM + wc * 32 + 8 * fq;
#pragma unroll
        for (int ai = 0; ai < 2; ++ai)
#pragma unroll
            for (int m = 0; m < 4; ++m) { bf16_t* rowp = O + (size_t)(row0 + ai * HALF + m * 16) * ldc + col0;
#pragma unroll
                for (int bj = 0; bj < 2; ++bj) { const f32x4 v0 = acc[ai][bj][m][0], v1 = acc[ai][bj][m][1];
                    u32x4 w; w.x = cvt_pk_bf16(v0[0], v0[1]); w.y = cvt_pk_bf16(v0[2], v0[3]); w.z = cvt_pk_bf16(v1[0], v1[1]); w.w = cvt_pk_bf16(v1[2], v1[3]);
                    *(u32x4*)(rowp + bj * HALF) = w; } }
    }
};
__device__ __forceinline__ float silu_f(float x) { return x * __builtin_amdgcn_rcpf(1.0f + __expf(-x)); }
struct EpiSwiGLU {
    static constexpr bool PERM = true, AFTER_DRAIN = false;
    bf16_t* O; int ldc;
    __device__ __forceinline__ void operator()(const f32x4 (&acc)[2][2][4][2], const Unit& u, int wr, int wc, int fr, int fq) const {
        const int row0 = u.pm * BM + wr * 64 + fr; const int col0 = u.pn * HALF + wc * 32 + 8 * fq;
#pragma unroll
        for (int ai = 0; ai < 2; ++ai)
#pragma unroll
            for (int m = 0; m < 4; ++m) { bf16_t* rowp = O + (size_t)(row0 + ai * HALF + m * 16) * ldc + col0;
                const f32x4 g0 = acc[ai][0][m][0], g1 = acc[ai][0][m][1], u0 = acc[ai][1][m][0], u1 = acc[ai][1][m][1];
                float h[8];
#pragma unroll
                for (int e = 0; e < 4; ++e) { h[e] = silu_f(g0[e]) * u0[e]; h[4 + e] = silu_f(g1[e]) * u1[e]; }
                u32x4 w; w.x = cvt_pk_bf16(h[0], h[1]); w.y = cvt_pk_bf16(h[2], h[3]); w.z = cvt_pk_bf16(h[4], h[5]); w.w = cvt_pk_bf16(h[6], h[7]);
                *(u32x4*)rowp = w; }
    }
};

template <class Epi, class Sched, bool ALIGN_EPI = false, bool SP2 = false>
__device__ __forceinline__ void gemm_phase(PG8_LAS unsigned char* lds, const Gemm g, const Sched& S, const Epi& E, const int tid) {
    const int wid = __builtin_amdgcn_readfirstlane(tid >> 6), lane = tid & 63, wr = wid >> 2, wc = wid & 3, fr = lane & 15, fq = lane >> 4;
    const int K = g.K, nt = K / BK;
    unsigned voffA[2], voffB[2];
#pragma unroll
    for (int i = 0; i < 2; ++i) { int R, C; stage_rc(tid * 16 + i * 8192, R, C); const int Rb = Epi::PERM ? ((R & ~31) + perm32(R & 31)) : R;
        voffA[i] = (unsigned)(R * K + C) * 2u; voffB[i] = (unsigned)(Rb * K + C) * 2u; }
    const size_t kstep = (size_t)(BK * 2);
    const size_t hstep = (size_t)HALF * K * 2;
    const size_t tstep = 2 * hstep;
    const unsigned ldsw = (unsigned)wid * 1024u;
    const int aoff = lds_byte(wr * 64 + fr, fq * 8), boff = lds_byte(wc * 32 + fr, fq * 8);
#define PG8_SA(b, h) (((b) * 2 + (h)) * HTB)
#define PG8_SB(b, h) ((4 + (b) * 2 + (h)) * HTB)
#define PG8_STAGE(bufoff, gbase, voff) do { _Pragma("unroll") for (int _i = 0; _i < 2; ++_i) \
        __builtin_amdgcn_global_load_lds((const unsigned*)((const char*)(gbase) + (voff)[_i]), (PG8_LAS unsigned*)(lds + (bufoff) + ldsw + _i * 8192), 16, 0, 0); } while (0)
#define PG8_LDA(dst, b, h) do { _Pragma("unroll") for (int m = 0; m < 4; ++m) _Pragma("unroll") for (int k = 0; k < 2; ++k) dst[m][k] = *(const PG8_LAS bf16x8*)(lds + PG8_SA(b, h) + aoff + m * 2048 + k * 1024); } while (0)
#define PG8_LDB(dst, b, h) do { _Pragma("unroll") for (int n = 0; n < 2; ++n) _Pragma("unroll") for (int k = 0; k < 2; ++k) dst[n][k] = *(const PG8_LAS bf16x8*)(lds + PG8_SB(b, h) + boff + n * 2048 + k * 1024); } while (0)
#define PG8_MMA(ai, bj, At, Bt) do { __builtin_amdgcn_s_setprio(1); _Pragma("unroll") for (int m = 0; m < 4; ++m) _Pragma("unroll") for (int n = 0; n < 2; ++n) _Pragma("unroll") for (int k = 0; k < 2; ++k) \
        acc[ai][bj][m][n] = __builtin_amdgcn_mfma_f32_16x16x32_bf16(Bt[n][k], At[m][k], acc[ai][bj][m][n], 0, 0, 0); __builtin_amdgcn_s_setprio(0); } while (0)
#define PG8_WAIT_V(n) asm volatile("s_waitcnt vmcnt(" #n ")" ::: "memory")
#define PG8_WAIT_L(n) asm volatile("s_waitcnt lgkmcnt(" #n ")" ::: "memory")
#define PG8_BAR __builtin_amdgcn_s_barrier()
#define PG8_SCHED __builtin_amdgcn_sched_barrier(0)
    Unit cur, nxt; int ui = 0;
    if (!S.next(0, cur)) return;
    f32x4 acc[2][2][4][2];
#pragma unroll
    for (int a = 0; a < 2; ++a)
#pragma unroll
        for (int b = 0; b < 2; ++b)
#pragma unroll
            for (int m = 0; m < 4; ++m)
#pragma unroll
                for (int n = 0; n < 2; ++n) acc[a][b][m][n] = (f32x4){0.f, 0.f, 0.f, 0.f};
    bf16x8 At[4][2], B0[2][2], B1[2][2];
    const char* cA = (const char*)g.A + (size_t)cur.pm * tstep; const char* cB = (const char*)g.Bt + (size_t)cur.pn * tstep;
    S.a_ready(cur);
    if constexpr (SP2) {
        PG8_STAGE(PG8_SB(0, 0), cB, voffB); PG8_STAGE(PG8_SB(0, 1), cB + hstep, voffB); PG8_STAGE(PG8_SA(0, 0), cA, voffA); PG8_STAGE(PG8_SA(0, 1), cA + hstep, voffA);
        if (wr == 1) PG8_BAR;
        PG8_WAIT_V(2); PG8_BAR;
        PG8_STAGE(PG8_SB(1, 0), cB + kstep, voffB); PG8_STAGE(PG8_SA(1, 0), cA + kstep, voffA); PG8_STAGE(PG8_SB(1, 1), cB + hstep + kstep, voffB);
        PG8_WAIT_V(6); PG8_BAR;
    } else {
        PG8_STAGE(PG8_SB(0, 0), cB, voffB); PG8_STAGE(PG8_SA(0, 0), cA, voffA); PG8_STAGE(PG8_SB(0, 1), cB + hstep, voffB); PG8_STAGE(PG8_SA(0, 1), cA + hstep, voffA);
        if (wr == 1) PG8_BAR;
        PG8_WAIT_V(4); PG8_BAR;
        PG8_STAGE(PG8_SB(1, 0), cB + kstep, voffB); PG8_STAGE(PG8_SA(1, 0), cA + kstep, voffA); PG8_STAGE(PG8_SB(1, 1), cB + hstep + kstep, voffB);
        PG8_WAIT_V(6); PG8_BAR;
    }
    for (;;) {
        const bool has_next = S.next(ui + 1, nxt);
        const char* nA = has_next ? (const char*)g.A + (size_t)nxt.pm * tstep : cA; const char* nB = has_next ? (const char*)g.Bt + (size_t)nxt.pn * tstep : cB;
        for (int t = 0; t < nt; t += 2) {
            const bool last = (t == nt - 2);
            const char* a1 = cA + (size_t)(t + 1) * kstep;
            const char* a2 = last ? nA : cA + (size_t)(t + 2) * kstep; const char* b2 = last ? nB : cB + (size_t)(t + 2) * kstep;
            const char* a3 = a2 + kstep; const char* b3 = b2 + kstep;
            if (last && has_next) S.a_ready(nxt);
            if constexpr (SP2) {
            PG8_LDB(B0, 0, 0); PG8_LDB(B1, 0, 1); PG8_SCHED; PG8_LDA(At, 0, 0); PG8_STAGE(PG8_SA(1, 1), a1 + hstep, voffA);
            PG8_WAIT_V(8); PG8_WAIT_L(0); PG8_BAR; PG8_MMA(0, 0, At, B0); PG8_MMA(0, 1, At, B1); PG8_BAR; PG8_SCHED;
            PG8_LDA(At, 0, 1); PG8_STAGE(PG8_SB(0, 0), b2, voffB); PG8_STAGE(PG8_SB(0, 1), b2 + hstep, voffB); PG8_STAGE(PG8_SA(0, 0), a2, voffA);
            PG8_WAIT_V(8); PG8_WAIT_L(0); PG8_BAR; PG8_MMA(1, 0, At, B0); PG8_MMA(1, 1, At, B1); PG8_BAR; PG8_SCHED;
            PG8_LDB(B0, 1, 0); PG8_LDB(B1, 1, 1); PG8_SCHED; PG8_LDA(At, 1, 0); PG8_STAGE(PG8_SA(0, 1), a2 + hstep, voffA);
            PG8_WAIT_V(8); PG8_WAIT_L(0); PG8_BAR; PG8_MMA(0, 0, At, B0); PG8_MMA(0, 1, At, B1); PG8_BAR; PG8_SCHED;
            PG8_LDA(At, 1, 1); PG8_STAGE(PG8_SB(1, 0), b3, voffB); PG8_STAGE(PG8_SB(1, 1), b3 + hstep, voffB); PG8_STAGE(PG8_SA(1, 0), a3, voffA);
            PG8_WAIT_V(8); PG8_WAIT_L(0); PG8_BAR; PG8_MMA(1, 0, At, B0); PG8_MMA(1, 1, At, B1); PG8_BAR; PG8_SCHED;
            } else {
            PG8_LDB(B0, 0, 0); PG8_SCHED; PG8_LDA(At, 0, 0); PG8_STAGE(PG8_SA(1, 1), a1 + hstep, voffA);
            PG8_WAIT_L(8); PG8_BAR; PG8_WAIT_L(0); PG8_MMA(0, 0, At, B0); PG8_BAR; PG8_SCHED;
            PG8_LDB(B1, 0, 1); PG8_STAGE(PG8_SB(0, 0), b2, voffB);
            PG8_BAR; PG8_WAIT_L(0); PG8_MMA(0, 1, At, B1); PG8_BAR;
            PG8_LDA(At, 0, 1); PG8_STAGE(PG8_SA(0, 0), a2, voffA);
            PG8_BAR; PG8_WAIT_L(0); PG8_MMA(1, 0, At, B0); PG8_BAR; PG8_SCHED;
            PG8_STAGE(PG8_SB(0, 1), b2 + hstep, voffB);
            PG8_WAIT_V(6); PG8_BAR; PG8_MMA(1, 1, At, B1); PG8_BAR;
            PG8_LDB(B0, 1, 0); PG8_SCHED; PG8_LDA(At, 1, 0); PG8_STAGE(PG8_SA(0, 1), a2 + hstep, voffA);
            PG8_WAIT_L(8); PG8_BAR; PG8_WAIT_L(0); PG8_MMA(0, 0, At, B0); PG8_BAR; PG8_SCHED;
            PG8_LDB(B1, 1, 1); PG8_STAGE(PG8_SB(1, 0), b3, voffB);
            PG8_BAR; PG8_WAIT_L(0); PG8_MMA(0, 1, At, B1); PG8_BAR;
            PG8_LDA(At, 1, 1); PG8_STAGE(PG8_SA(1, 0), a3, voffA);
            PG8_BAR; PG8_WAIT_L(0); PG8_MMA(1, 0, At, B0); PG8_BAR; PG8_SCHED;
            PG8_STAGE(PG8_SB(1, 1), b3 + hstep, voffB);
            PG8_WAIT_V(6); PG8_BAR; PG8_MMA(1, 1, At, B1); PG8_BAR;
            }
        }
        if constexpr (ALIGN_EPI) { if (wr == 0) PG8_BAR; }
        if constexpr (!Epi::AFTER_DRAIN) { E(acc, cur, wr, wc, fr, fq); S.done(cur); }
        if (!has_next) break;
#pragma unroll
        for (int a = 0; a < 2; ++a)
#pragma unroll
            for (int b = 0; b < 2; ++b)
#pragma unroll
                for (int m = 0; m < 4; ++m)
#pragma unroll
                    for (int n = 0; n < 2; ++n) acc[a][b][m][n] = (f32x4){0.f, 0.f, 0.f, 0.f};
        cur = nxt; cA = nA; cB = nB; ++ui;
        if constexpr (ALIGN_EPI) { if (wr == 1) PG8_BAR; }
    }
    PG8_WAIT_V(0);
    if constexpr (!ALIGN_EPI) { if (wr == 0) PG8_BAR; }
    PG8_BAR;
#undef PG8_SA
#undef PG8_SB
#undef PG8_STAGE
#undef PG8_LDA
#undef PG8_LDB
#undef PG8_MMA
#undef PG8_WAIT_V
#undef PG8_WAIT_L
#undef PG8_BAR
#undef PG8_SCHED
}
}

constexpr int NWAVES = 8;
constexpr int BATCH = 8, SEQ = 2048, DM = 1024, M = BATCH * SEQ, DFF = 2816, DEPTH = 2;
constexpr int GW = 256, NH = 4, HD = 64;
constexpr int INC = 2688, INP = 2816;
constexpr int CA = 0, CB = 768, CC = 1280, CD = 2176;
constexpr float RMS_EPS = 1e-6f, LN_EPS = 1e-5f, GN_EPS = 1e-5f * 64.f;

enum { I_X = 0, I_F1PRE, I_F1G, I_F1U, I_F1D, I_F1POST, I_MIXPRE, I_WIN, I_SCW, I_SGLNW, I_SGLNB, I_SGW, I_SGB, I_MU, I_W0, I_WUP, I_A0, I_AUP, I_GUP, I_KK, I_KA, I_RK,
       I_RLNW, I_RLNB, I_CMW, I_CMB, I_CMLNW, I_CMLNB, I_WOUT, I_MIXPOST, I_F2PRE, I_F2G, I_F2U, I_F2D, I_F2POST, N_IN };

constexpr size_t MiB = 1u << 20;
constexpr size_t WS_CTL = 0, CTL_ZERO_BYTES = 1 * MiB;
constexpr size_t WS_WGU1 = 1 * MiB;
constexpr size_t WS_WD1 = 12 * MiB;
constexpr size_t WS_WIN = WS_WD1 + 5 * MiB + MiB / 2;
constexpr size_t WS_WOUT = 23 * MiB;
constexpr size_t WS_WGU2 = 25 * MiB;
constexpr size_t WS_WD2 = 36 * MiB;
constexpr size_t WS_PH = 42 * MiB;
constexpr size_t WS_HB = 130 * MiB;
constexpr size_t WS_Y = 162 * MiB;
constexpr size_t WS_G = WS_Y, WS_O = WS_Y + 8 * MiB, WS_BONUS = WS_Y + 24 * MiB;
constexpr size_t WS_R = 194 * MiB, WS_K = 202 * MiB, WS_V = 210 * MiB, WS_KKN = 218 * MiB, WS_BV = 226 * MiB, WS_WDEC = 234 * MiB;
constexpr size_t WS_END = 250 * MiB;
constexpr int CW_BAR = 4096;

constexpr int RING_BYTES = 131072;
constexpr int LDSCTL_OFF = RING_BYTES, MISC_OFF = LDSCTL_OFF + 320;
constexpr int LDS_BYTES = 147456;

#define GAS __attribute__((address_space(1)))
#define LAS __attribute__((address_space(3)))
typedef unsigned short bf16;
typedef unsigned v4u __attribute__((ext_vector_type(4)));
typedef unsigned v2u __attribute__((ext_vector_type(2)));
typedef float f32x4 __attribute__((ext_vector_type(4)));
typedef float f32x16 __attribute__((ext_vector_type(16)));
typedef short bf16x8 __attribute__((ext_vector_type(8)));
typedef GAS unsigned gu32;
#define LDS_WAIT() asm volatile("s_waitcnt lgkmcnt(0)" ::: "memory")
#define VM_WAIT() asm volatile("s_waitcnt vmcnt(0)" ::: "memory")
__device__ __forceinline__ unsigned f2bf(float f) { unsigned u = __builtin_bit_cast(unsigned, f); return (u + 0x7fffu + ((u >> 16) & 1u)) >> 16; }
__device__ __forceinline__ unsigned pk2(float lo, float hi) { return f2bf(lo) | (f2bf(hi) << 16); }
__device__ __forceinline__ float bf2f(unsigned h) { return __builtin_bit_cast(float, h << 16); }
__device__ __forceinline__ float bflo(unsigned w) { return __builtin_bit_cast(float, w << 16); }
__device__ __forceinline__ float bfhi(unsigned w) { return __builtin_bit_cast(float, w & 0xffff0000u); }
__device__ __forceinline__ float sigmoid_f(float x) { return __builtin_amdgcn_rcpf(1.0f + __expf(-x)); }

#define XB_TMO      128
#define XB_XCNT(j)  (256  + 64 * (j))
#define XB_XSUB(j)  (1280 + 64 * (j))
#define XB_XGEN(j)  (2304 + 64 * (j))
#define XB_TOP      3328
#define XB_TOPGEN   3392
#define XCD_BAR_WORDS 3456
#define XB_SPIN_CAP (1u << 20)
__device__ __forceinline__ unsigned xb_ld(unsigned* p)              { return __hip_atomic_load(p, __ATOMIC_RELAXED, __HIP_MEMORY_SCOPE_AGENT); }
__device__ __forceinline__ unsigned xb_add(unsigned* p, unsigned v) { return __hip_atomic_fetch_add(p, v, __ATOMIC_RELAXED, __HIP_MEMORY_SCOPE_AGENT); }
__device__ __forceinline__ unsigned xb_xcc_id() { return (unsigned)__builtin_amdgcn_s_getreg((3 << 11) | 20) & 0xFu; }
#define XB_SPIN(cond, bar) do { unsigned _sp = 0; while (cond) { __builtin_amdgcn_s_sleep(1); \
    if ((++_sp & 255u) == 0u) { if (xb_ld(&(bar)[XB_TMO])) break; if (_sp > XB_SPIN_CAP) { atomicAdd(&(bar)[XB_TMO], 1u); break; } } } } while (0)
struct XcdBarrier { unsigned* bar; unsigned x; volatile LAS unsigned* st; };
__device__ __forceinline__ XcdBarrier xcd_barrier_post(unsigned* bar, volatile LAS unsigned* st) {
    XcdBarrier b; b.bar = bar; b.x = xb_xcc_id(); b.st = st;
    if (threadIdx.x == 0) (void)xb_add(&bar[XB_XCNT(b.x)], 1u);
    return b;
}
__device__ __forceinline__ void xcd_barrier_complete(unsigned* bar, unsigned x, unsigned& nloc, unsigned& nx) {
    const unsigned G = gridDim.x * gridDim.y * gridDim.z;
    unsigned sum, cnt, mine, sp = 0u;
    for (;;) {
        sum = 0u; cnt = 0u; mine = 0u;
#pragma unroll
        for (unsigned j = 0; j < 16; ++j) { const unsigned c = xb_ld(&bar[XB_XCNT(j)]); sum += c; cnt += (c > 0u) ? 1u : 0u; mine = (j == x) ? c : mine; }
        if (sum == G) break;
        __builtin_amdgcn_s_sleep(1);
        if ((++sp & 255u) == 0u) { if (xb_ld(&bar[XB_TMO])) break; if (sp > XB_SPIN_CAP) { atomicAdd(&bar[XB_TMO], 1u); break; } }
    }
    nloc = mine > 0u ? mine : 1u; nx = cnt > 0u ? cnt : 1u;
}
__device__ __forceinline__ void xcd_barrier(const XcdBarrier& b) {
    asm volatile("s_waitcnt vmcnt(0)" ::: "memory");
    __syncthreads();
    if (threadIdx.x == 0) {
        unsigned* bar = b.bar;
        __builtin_amdgcn_s_waitcnt(0);
        unsigned nloc = b.st[0], nx = b.st[1];
        if (nloc == 0u) { xcd_barrier_complete(bar, b.x, nloc, nx); b.st[0] = nloc; b.st[1] = nx; }
        const unsigned old = xb_add(&bar[XB_XSUB(b.x)], 1u);
        const unsigned gen = old / nloc;
        if (old + 1u == (gen + 1u) * nloc) {
            __builtin_amdgcn_fence(__ATOMIC_RELEASE, "agent");
            asm volatile("s_waitcnt vmcnt(0)" ::: "memory");
            const unsigned og = xb_add(&bar[XB_TOP], 1u);
            const unsigned tg = og / nx;
            if (og + 1u == (tg + 1u) * nx) xb_add(&bar[XB_TOPGEN], 1u);
            else XB_SPIN(xb_ld(&bar[XB_TOPGEN]) == tg, bar);
            __builtin_amdgcn_fence(__ATOMIC_ACQUIRE, "agent");
            xb_add(&bar[XB_XGEN(b.x)], 1u);
            asm volatile("s_waitcnt vmcnt(0)" ::: "memory");
        } else {
            XB_SPIN(xb_ld(&bar[XB_XGEN(b.x)]) == gen, bar);
            __builtin_amdgcn_fence(__ATOMIC_ACQUIRE, "agent");
            asm volatile("s_waitcnt vmcnt(0)" ::: "memory");
        }
    }
    __syncthreads();
}

__device__ __forceinline__ float wave_sum(float v) {
#pragma unroll
    for (int o = 1; o < 64; o <<= 1) v += __shfl_xor(v, o);
    return v;
}
__device__ __forceinline__ float sum8(float v) {
    v += __builtin_bit_cast(float, __builtin_amdgcn_update_dpp(0, __builtin_bit_cast(int, v), 0xB1, 0xf, 0xf, true));
    v += __builtin_bit_cast(float, __builtin_amdgcn_update_dpp(0, __builtin_bit_cast(int, v), 0x4E, 0xf, 0xf, true));
    v += __builtin_bit_cast(float, __builtin_amdgcn_update_dpp(0, __builtin_bit_cast(int, v), 0x141, 0xf, 0xf, true));
    return v;
}

struct Ctx {
    LAS unsigned char* lds;
    int tid, lane, wave, vcu, G;
    const float* const* in;
};

__device__ __forceinline__ void transpose_item(const float* W, int K, int N, bf16* WT, int row_off, LAS float* scr, int item, int lane) {
    const int nblk = N / 32, kb = item / nblk, nb = item % nblk, k0 = 64 * kb, n0 = 32 * nb;
#pragma unroll 8
    for (int i = 0; i < 32; ++i) { const int kk = 2 * i + (lane >> 5); scr[kk * 33 + (lane & 31)] = W[(size_t)(k0 + kk) * N + n0 + (lane & 31)]; }
    LDS_WAIT(); asm volatile("" ::: "memory");
    const int c = lane & 7;
#pragma unroll
    for (int j = 0; j < 4; ++j) { const int n = (lane >> 3) + 8 * j; const LAS float* s = scr + (8 * c) * 33 + n;
        v4u o; o.x = pk2(s[0 * 33], s[1 * 33]); o.y = pk2(s[2 * 33], s[3 * 33]); o.z = pk2(s[4 * 33], s[5 * 33]); o.w = pk2(s[6 * 33], s[7 * 33]);
        *(v4u*)(WT + (size_t)(row_off + n0 + n) * K + k0 + 8 * c) = o; }
    LDS_WAIT(); asm volatile("" ::: "memory");
}
__device__ __forceinline__ void transpose_item_gu(const float* W, bf16* WT, int up, LAS float* scr, int item, int lane) {
    const int nblk = DFF / 32, nb = item % nblk, n0 = 32 * nb;
    const int dest0 = (n0 / 128) * 256 + (n0 % 128) + up * 128;
    transpose_item(W, DM, DFF, WT, dest0 - n0, scr, item, lane);
}

struct Args { const float* in[N_IN]; float* out; unsigned char* ws; int ph_lo, ph_hi; };

__device__ __forceinline__ void convert_weights(const Args& a, int l, LAS unsigned char* lds, int gw, int NGW, int wave, int lane) {
    LAS float* scr = (LAS float*)(lds + wave * 16384);
    constexpr int I_GU = (DM / 64) * (DFF / 32), I_DN = (DFF / 64) * (DM / 32), I_IN = (DM / 64) * (INC / 32), I_OUT = (DM / 64) * (DM / 32);
    constexpr int NITEMS = 4 * I_GU + 2 * I_DN + I_IN + I_OUT;
    unsigned char* ws = a.ws;
    const size_t oGU = (size_t)l * DM * DFF, oIN = (size_t)l * DM * INC, oOUT = (size_t)l * DM * DM;
    for (int it = gw; it < NITEMS; it += NGW) {
        int r = it;
        if (r < I_GU) { transpose_item_gu(a.in[I_F1G] + oGU, (bf16*)(ws + WS_WGU1), 0, scr, r, lane); continue; } r -= I_GU;
        if (r < I_GU) { transpose_item_gu(a.in[I_F1U] + oGU, (bf16*)(ws + WS_WGU1), 1, scr, r, lane); continue; } r -= I_GU;
        if (r < I_GU) { transpose_item_gu(a.in[I_F2G] + oGU, (bf16*)(ws + WS_WGU2), 0, scr, r, lane); continue; } r -= I_GU;
        if (r < I_GU) { transpose_item_gu(a.in[I_F2U] + oGU, (bf16*)(ws + WS_WGU2), 1, scr, r, lane); continue; } r -= I_GU;
        if (r < I_DN) { transpose_item(a.in[I_F1D] + oGU, DFF, DM, (bf16*)(ws + WS_WD1), 0, scr, r, lane); continue; } r -= I_DN;
        if (r < I_DN) { transpose_item(a.in[I_F2D] + oGU, DFF, DM, (bf16*)(ws + WS_WD2), 0, scr, r, lane); continue; } r -= I_DN;
        if (r < I_IN) { transpose_item(a.in[I_WIN] + oIN, DM, INC, (bf16*)(ws + WS_WIN), 0, scr, r, lane); continue; } r -= I_IN;
        transpose_item(a.in[I_WOUT] + oOUT, DM, DM, (bf16*)(ws + WS_WOUT), 0, scr, r, lane);
    }
    { v4u* z = (v4u*)((bf16*)(ws + WS_WIN) + (size_t)INC * DM); const int n16 = (INP - INC) * DM * 2 / 16;
      for (int i = gw * 64 + lane; i < n16; i += NGW * 64) z[i] = (v4u){0u, 0u, 0u, 0u}; }
}

__device__ __forceinline__ void row_phase(const float* xsrc, float* xdst, const bf16* y, const float* gpost, float scale, const float* gnext, bf16* hb, int gw, int NGW, int lane) {
    for (int m = gw; m < M; m += NGW) {
        const f32x4* xr = (const f32x4*)(xsrc + (size_t)m * DM) + lane;
        f32x4 v[4];
#pragma unroll
        for (int j = 0; j < 4; ++j) v[j] = xr[64 * j];
        if (y) {
            const v2u* yr = (const v2u*)(y + (size_t)m * DM) + lane; f32x4 yv[4]; float s = 0.f;
#pragma unroll
            for (int j = 0; j < 4; ++j) { const v2u w = yr[64 * j]; yv[j] = (f32x4){bflo(w.x), bfhi(w.x), bflo(w.y), bfhi(w.y)}; s += (yv[j].x * yv[j].x + yv[j].y * yv[j].y) + (yv[j].z * yv[j].z + yv[j].w * yv[j].w); }
            const float rs = scale * __builtin_amdgcn_rsqf(wave_sum(s) * (1.f / DM) + RMS_EPS);
#pragma unroll
            for (int j = 0; j < 4; ++j) { const f32x4 g = ((const f32x4*)gpost)[64 * j + lane]; v[j] = v[j] + (yv[j] * rs) * g; }
        }
        if (y || xsrc != xdst) { f32x4* xo = (f32x4*)(xdst + (size_t)m * DM) + lane;
#pragma unroll
            for (int j = 0; j < 4; ++j) xo[64 * j] = v[j]; }
        if (gnext) {
            float s2 = 0.f;
#pragma unroll
            for (int j = 0; j < 4; ++j) s2 += (v[j].x * v[j].x + v[j].y * v[j].y) + (v[j].z * v[j].z + v[j].w * v[j].w);
            const float rs2 = __builtin_amdgcn_rsqf(wave_sum(s2) * (1.f / DM) + RMS_EPS);
            v2u* ho = (v2u*)(hb + (size_t)m * DM) + lane;
#pragma unroll
            for (int j = 0; j < 4; ++j) { const f32x4 g = ((const f32x4*)gnext)[64 * j + lane]; const f32x4 h = (v[j] * rs2) * g; v2u w; w.x = pk2(h.x, h.y); w.y = pk2(h.z, h.w); ho[64 * j] = w; }
        }
    }
}

__device__ __forceinline__ void mixA_unit(const bf16* P, const float* scw, bf16* ycat, int unit, int tid) {
    const int b = unit >> 5, t0 = (unit & 31) * 64;
    const int cp = tid & 127, tg = tid >> 7, c = 2 * cp;
    const float w0a = scw[c], w0b = scw[c + 1], w1a = scw[GW + c], w1b = scw[GW + c + 1], w2a = scw[2 * GW + c], w2b = scw[2 * GW + c + 1];
    const int ts = t0 + tg * 16;
    float g2a = 0.f, g2b = 0.f, g1a = 0.f, g1b = 0.f;
    const bf16* prow = P + (size_t)(b * SEQ) * INP;
    if (ts >= 2) { const unsigned gc = *(const unsigned*)(prow + (size_t)(ts - 2) * INP + CA + 256 + c), xa = *(const unsigned*)(prow + (size_t)(ts - 2) * INP + CA + 512 + c); g2a = bflo(gc) * bflo(xa); g2b = bfhi(gc) * bfhi(xa); }
    if (ts >= 1) { const unsigned gc = *(const unsigned*)(prow + (size_t)(ts - 1) * INP + CA + 256 + c), xa = *(const unsigned*)(prow + (size_t)(ts - 1) * INP + CA + 512 + c); g1a = bflo(gc) * bflo(xa); g1b = bfhi(gc) * bfhi(xa); }
#pragma unroll 4
    for (int i = 0; i < 16; ++i) {
        const bf16* pr = prow + (size_t)(ts + i) * INP + CA;
        const unsigned gb = *(const unsigned*)(pr + c), gc = *(const unsigned*)(pr + 256 + c), xa = *(const unsigned*)(pr + 512 + c);
        const float g0a = bflo(gc) * bflo(xa), g0b = bfhi(gc) * bfhi(xa);
        const float ya = bflo(gb) * (w0a * g2a + w1a * g1a + w2a * g0a), yb = bfhi(gb) * (w0b * g2b + w1b * g1b + w2b * g0b);
        *(unsigned*)(ycat + (size_t)(b * SEQ + ts + i) * DM + c) = pk2(ya, yb);
        g2a = g1a; g2b = g1b; g1a = g0a; g1b = g0b;
    }
}

__device__ __forceinline__ void mixD_unit(const bf16* P, const float* cw, const float* cb, const float* lnw, const float* lnb, bf16* ycat, LAS unsigned char* lds, int unit, int tid, int wave, int lane) {
    const int b = unit >> 5, t0 = (unit & 31) * 64;
    LAS float* L = (LAS float*)lds;
    const bf16* prow = P + (size_t)(b * SEQ) * INP + CD;
    for (int idx = tid; idx < 94 * 128; idx += 512) {
        const int s = idx >> 7, cp = idx & 127, tok = t0 - 30 + s; float ga = 0.f, gb = 0.f;
        if (tok >= 0) { const unsigned z1 = *(const unsigned*)(prow + (size_t)tok * INP + 2 * cp), z2 = *(const unsigned*)(prow + (size_t)tok * INP + 256 + 2 * cp);
            ga = bflo(z1) * sigmoid_f(bflo(z2)); gb = bfhi(z1) * sigmoid_f(bfhi(z2)); }
        L[s * 256 + 2 * cp] = ga; L[s * 256 + 2 * cp + 1] = gb;
    }
    __syncthreads();
    const int c = tid & 255, tg = tid >> 8;
    float w[31];
#pragma unroll
    for (int j = 0; j < 31; ++j) w[j] = cw[j * GW + c];
    const float bias = cb[c];
    float res[32];
#pragma unroll
    for (int ps = 0; ps < 2; ++ps) {
        float acc[16];
#pragma unroll
        for (int i = 0; i < 16; ++i) acc[i] = bias;
#pragma unroll
        for (int s = 0; s < 46; ++s) {
            const float gv = L[(tg * 32 + ps * 16 + s) * 256 + c];
#pragma unroll
            for (int tt = 0; tt < 16; ++tt) { const int j = s - tt; if (j >= 0 && j <= 30) acc[tt] += w[j] * gv; }
        }
#pragma unroll
        for (int i = 0; i < 16; ++i) res[ps * 16 + i] = acc[i];
        asm volatile("" ::: "memory");
    }
    __syncthreads();
#pragma unroll
    for (int tt = 0; tt < 32; ++tt) L[(tg * 32 + tt) * 256 + c] = res[tt];
    __syncthreads();
    const f32x4 gw4 = ((const f32x4*)lnw)[lane], gb4 = ((const f32x4*)lnb)[lane];
#pragma unroll 2
    for (int i = 0; i < 8; ++i) {
        const int tt = wave * 8 + i; const f32x4 z = *(const LAS f32x4*)(L + tt * 256 + 4 * lane);
        const float mean = wave_sum((z.x + z.y) + (z.z + z.w)) * (1.f / 256.f);
        const f32x4 d = z - mean; const float var = wave_sum((d.x * d.x + d.y * d.y) + (d.z * d.z + d.w * d.w)) * (1.f / 256.f);
        const float rstd = __builtin_amdgcn_rsqf(var + LN_EPS);
        f32x4 o = (d * rstd) * gw4 + gb4; o.x = pg8::silu_f(o.x); o.y = pg8::silu_f(o.y); o.z = pg8::silu_f(o.z); o.w = pg8::silu_f(o.w);
        v2u wv; wv.x = pk2(o.x, o.y); wv.y = pk2(o.z, o.w);
        *(v2u*)(ycat + (size_t)(b * SEQ + t0 + tt) * DM + 768 + 4 * lane) = wv;
    }
    __syncthreads();
}

__device__ __forceinline__ void mixB_unit(const bf16* P, const float* lnw, const float* lnb, const float* sgw, const float* sgb, bf16* ycat, LAS unsigned char* lds, int unit, int tid, int wave, int lane) {
    const int b = unit >> 4, n = unit & 15, tok0 = b * SEQ + n * 128;
    LAS bf16* VT = (LAS bf16*)lds;
    {
        const f32x4 gw4 = ((const f32x4*)lnw)[lane], gb4 = ((const f32x4*)lnb)[lane];
#pragma unroll 4
        for (int i = 0; i < 16; ++i) {
            const int s = wave * 16 + i; const v2u w = *(const v2u*)(P + (size_t)(tok0 + s) * INP + CB + 256 + 4 * lane);
            const f32x4 v = (f32x4){bflo(w.x), bfhi(w.x), bflo(w.y), bfhi(w.y)};
            const float mean = wave_sum((v.x + v.y) + (v.z + v.w)) * (1.f / 256.f);
            const f32x4 d = v - mean; const float var = wave_sum((d.x * d.x + d.y * d.y) + (d.z * d.z + d.w * d.w)) * (1.f / 256.f);
            const float rstd = __builtin_amdgcn_rsqf(var + LN_EPS);
            const f32x4 o = (d * rstd) * gw4 + gb4;
            VT[(4 * lane + 0) * 136 + s] = (bf16)f2bf(o.x); VT[(4 * lane + 1) * 136 + s] = (bf16)f2bf(o.y);
            VT[(4 * lane + 2) * 136 + s] = (bf16)f2bf(o.z); VT[(4 * lane + 3) * 136 + s] = (bf16)f2bf(o.w);
        }
    }
    __syncthreads();
    const int h = wave >> 1, rh = wave & 1, r = lane & 31, hh = lane >> 5;
#pragma unroll
    for (int ti = 0; ti < 2; ++ti) {
        const int i = ti == 0 ? rh : 3 - rh;
        f32x16 acc0, acc1;
#pragma unroll
        for (int e = 0; e < 16; ++e) { acc0[e] = 0.f; acc1[e] = 0.f; }
        const int nks = 2 * (i + 1), t = 32 * i + r;
        const float* wrow = sgw + ((size_t)h * 128 + t) * 128;
        for (int ks = 0; ks < nks; ++ks) {
            const int s0 = 16 * ks + 8 * hh;
            const f32x4 wa = *(const f32x4*)(wrow + s0), wb = *(const f32x4*)(wrow + s0 + 4);
            float wv[8] = {wa.x, wa.y, wa.z, wa.w, wb.x, wb.y, wb.z, wb.w};
            bf16x8 A;
#pragma unroll
            for (int e = 0; e < 8; ++e) A[e] = (short)f2bf((s0 + e <= t) ? wv[e] : 0.f);
            const bf16x8 B0 = *(const LAS bf16x8*)(VT + (64 * h + r) * 136 + s0), B1 = *(const LAS bf16x8*)(VT + (64 * h + 32 + r) * 136 + s0);
            acc0 = __builtin_amdgcn_mfma_f32_32x32x16_bf16(A, B0, acc0, 0, 0, 0);
            acc1 = __builtin_amdgcn_mfma_f32_32x32x16_bf16(A, B1, acc1, 0, 0, 0);
        }
#pragma unroll
        for (int reg = 0; reg < 16; ++reg) {
            const int row = (reg & 3) + 8 * (reg >> 2) + 4 * hh, tt = 32 * i + row; const size_t tok = (size_t)(tok0 + tt);
            const float bias = sgb[h * 128 + tt];
            const int c0 = 64 * h + r;
            const float u0 = bf2f(P[tok * INP + CB + c0]), u1 = bf2f(P[tok * INP + CB + c0 + 32]);
            ycat[tok * DM + 256 + c0] = (bf16)f2bf(u0 * (acc0[reg] + bias));
            ycat[tok * DM + 256 + c0 + 32] = (bf16)f2bf(u1 * (acc1[reg] + bias));
        }
    }
    __syncthreads();
}

struct RwkvW { const float *mu, *w0, *wup, *a0, *aup, *gup, *kk, *ka, *rk; };
__device__ __forceinline__ void rwkv_prep_unit(const bf16* P, const RwkvW& W, unsigned char* ws, LAS unsigned char* lds, int unit, int tid, int lane) {
    const int b = unit >> 5, t0 = (unit & 31) * 64;
    LAS float* L = (LAS float*)lds;
    const bf16* prow = P + (size_t)(b * SEQ) * INP + CC;
    for (int idx = tid; idx < 64 * 128; idx += 512) {
        const int tt = idx >> 7, j = idx & 127, tok = t0 + tt;
        const float cur = bf2f(prow[(size_t)tok * INP + 768 + j]); const float prev = tok > 0 ? bf2f(prow[(size_t)(tok - 1) * INP + 768 + j]) : 0.f;
        const float xs = cur + (prev - cur) * W.mu[768 + j];
        float o; if (j < 32) o = tanhf(xs); else if (j < 64) o = xs; else o = sigmoid_f(xs);
        L[tt * 128 + j] = o;
    }
    __syncthreads();
    const int c = tid & 255, th = tid >> 8, hd = c >> 6;
    const int ts = t0 + th * 32;
    bf16* Rb = (bf16*)(ws + WS_R); bf16* Kb = (bf16*)(ws + WS_K); bf16* Vb = (bf16*)(ws + WS_V); bf16* KKb = (bf16*)(ws + WS_KKN); bf16* Bb = (bf16*)(ws + WS_BV);
    float* Wd = (float*)(ws + WS_WDEC); bf16* Gb = (bf16*)(ws + WS_G); float* Bon = (float*)(ws + WS_BONUS);
    const size_t tokb = (size_t)(b * SEQ + ts);
    {
        float wup[32];
#pragma unroll
        for (int j = 0; j < 32; ++j) wup[j] = W.wup[j * GW + c];
        const float w0 = W.w0[c];
#pragma nounroll
        for (int i = 0; i < 32; ++i) {
            const LAS f32x4* Lr = (const LAS f32x4*)(L + (th * 32 + i) * 128);
            float z0 = w0, z1 = 0.f;
#pragma unroll
            for (int j4 = 0; j4 < 8; j4 += 2) { const f32x4 x = Lr[j4], y = Lr[j4 + 1];
                z0 += x.x * wup[4 * j4] + x.y * wup[4 * j4 + 1] + x.z * wup[4 * j4 + 2] + x.w * wup[4 * j4 + 3];
                z1 += y.x * wup[4 * j4 + 4] + y.y * wup[4 * j4 + 5] + y.z * wup[4 * j4 + 6] + y.w * wup[4 * j4 + 7]; }
            const float nz = -(z0 + z1); const float sp = fmaxf(nz, 0.f) + log1pf(__expf(-fabsf(nz)));
            Wd[(tokb + i) * GW + c] = __expf(-__expf(-sp - 0.5f));
        }
    }
    {
        float gup[64];
#pragma unroll
        for (int j = 0; j < 64; ++j) gup[j] = W.gup[j * GW + c];
#pragma nounroll
        for (int i = 0; i < 32; ++i) {
            const LAS f32x4* Lr = (const LAS f32x4*)(L + (th * 32 + i) * 128 + 64);
            float g0 = 0.f, g1 = 0.f;
#pragma unroll
            for (int j4 = 0; j4 < 16; j4 += 2) { const f32x4 x = Lr[j4], y = Lr[j4 + 1];
                g0 += x.x * gup[4 * j4] + x.y * gup[4 * j4 + 1] + x.z * gup[4 * j4 + 2] + x.w * gup[4 * j4 + 3];
                g1 += y.x * gup[4 * j4 + 4] + y.y * gup[4 * j4 + 5] + y.z * gup[4 * j4 + 6] + y.w * gup[4 * j4 + 7]; }
            Gb[(tokb + i) * GW + c] = (bf16)f2bf(g0 + g1);
        }
    }
    {
        float aup[32];
#pragma unroll
        for (int j = 0; j < 32; ++j) aup[j] = W.aup[j * GW + c];
        const float mur = W.mu[c], muk = W.mu[256 + c], muv = W.mu[512 + c], a0 = W.a0[c], kkc = W.kk[c], kac = W.ka[c], rkc = W.rk[c];
        float pr = 0.f, pk = 0.f, pv = 0.f;
        if (ts > 0) { const bf16* q = prow + (size_t)(ts - 1) * INP; pr = bf2f(q[c]); pk = bf2f(q[256 + c]); pv = bf2f(q[512 + c]); }
#pragma nounroll
        for (int i = 0; i < 32; ++i) {
            const size_t tok = tokb + i;
            const bf16* q = prow + (size_t)(ts + i) * INP;
            const float cr = bf2f(q[c]), ck = bf2f(q[256 + c]), cv = bf2f(q[512 + c]);
            const float r = cr + (pr - cr) * mur, k = ck + (pk - ck) * muk, v = cv + (pv - cv) * muv;
            pr = cr; pk = ck; pv = cv;
            const LAS f32x4* Lr = (const LAS f32x4*)(L + (th * 32 + i) * 128 + 32);
            float z0 = a0, z1 = 0.f;
#pragma unroll
            for (int j4 = 0; j4 < 8; j4 += 2) { const f32x4 x = Lr[j4], y = Lr[j4 + 1];
                z0 += x.x * aup[4 * j4] + x.y * aup[4 * j4 + 1] + x.z * aup[4 * j4 + 2] + x.w * aup[4 * j4 + 3];
                z1 += y.x * aup[4 * j4 + 4] + y.y * aup[4 * j4 + 5] + y.z * aup[4 * j4 + 6] + y.w * aup[4 * j4 + 7]; }
            const float asig = sigmoid_f(z0 + z1);
            float kk = k * kkc; const float nrm = sqrtf(wave_sum(kk * kk)); kk = kk / fmaxf(nrm, 1e-12f);
            const float k2 = k * (1.f + (asig - 1.f) * kac);
            const float bon = wave_sum(r * k2 * rkc);
            Rb[tok * GW + c] = (bf16)f2bf(r); Kb[tok * GW + c] = (bf16)f2bf(k2); Vb[tok * GW + c] = (bf16)f2bf(v); KKb[tok * GW + c] = (bf16)f2bf(kk); Bb[tok * GW + c] = (bf16)f2bf(kk * asig);
            if (lane == 0) Bon[tok * NH + hd] = bon;
        }
    }
    __syncthreads();
}

constexpr int SC_T = 32, SC_STEP = 6 * 64, SC_BUF = SC_T * SC_STEP;
__device__ __forceinline__ void scan_load(float (&reg)[24], const unsigned char* ws, size_t tokbase, int ch0, int tid) {
    const size_t o = (tokbase + (tid >> 4)) * GW + ch0 + 4 * (tid & 15);
    const v2u kk = *(const v2u*)((const bf16*)(ws + WS_KKN) + o), bb = *(const v2u*)((const bf16*)(ws + WS_BV) + o), k = *(const v2u*)((const bf16*)(ws + WS_K) + o),
              r = *(const v2u*)((const bf16*)(ws + WS_R) + o), v = *(const v2u*)((const bf16*)(ws + WS_V) + o);
    const f32x4 w = *(const f32x4*)((const float*)(ws + WS_WDEC) + o);
    reg[0] = -bflo(kk.x); reg[1] = -bfhi(kk.x); reg[2] = -bflo(kk.y); reg[3] = -bfhi(kk.y);
    reg[4] = bflo(bb.x); reg[5] = bfhi(bb.x); reg[6] = bflo(bb.y); reg[7] = bfhi(bb.y);
    reg[8] = bflo(k.x); reg[9] = bfhi(k.x); reg[10] = bflo(k.y); reg[11] = bfhi(k.y);
    reg[12] = bflo(r.x); reg[13] = bfhi(r.x); reg[14] = bflo(r.y); reg[15] = bfhi(r.y);
    reg[16] = w.x; reg[17] = w.y; reg[18] = w.z; reg[19] = w.w;
    reg[20] = bflo(v.x); reg[21] = bfhi(v.x); reg[22] = bflo(v.y); reg[23] = bfhi(v.y);
}
__device__ __forceinline__ void scan_store(const float (&reg)[24], LAS float* buf, int tid) {
    LAS float* st = buf + (tid >> 4) * SC_STEP + 4 * (tid & 15);
#pragma unroll
    for (int a = 0; a < 6; ++a) *(LAS f32x4*)(st + 64 * a) = (f32x4){reg[4 * a], reg[4 * a + 1], reg[4 * a + 2], reg[4 * a + 3]};
}
__device__ __forceinline__ void scan_unit(unsigned char* ws, LAS unsigned char* lds, int unit, int tid) {
    const int b = unit >> 2, h = unit & 3, ch0 = 64 * h; const size_t tok0 = (size_t)b * SEQ;
    LAS float* BUF = (LAS float*)lds;
    LAS float* YB = (LAS float*)(lds + 2 * SC_BUF * 4);
    float* O = (float*)(ws + WS_O);
    const int i = tid >> 3, q = tid & 7;
    float S[8];
#pragma unroll
    for (int j = 0; j < 8; ++j) S[j] = 0.f;
    float reg[24];
    scan_load(reg, ws, tok0, ch0, tid);
    scan_store(reg, BUF, tid);
    __syncthreads();
    constexpr int NCH = SEQ / SC_T;
#pragma nounroll
    for (int ch = 0; ch < NCH; ++ch) {
        LAS float* cur = BUF + (ch & 1) * SC_BUF; LAS float* yb = YB + (ch & 1) * (SC_T * 64);
        if (ch + 1 < NCH) scan_load(reg, ws, tok0 + (size_t)(ch + 1) * SC_T, ch0, tid);
        if (ch > 0) {
            LAS float* py = YB + ((ch - 1) & 1) * (SC_T * 64);
#pragma unroll
            for (int e = 0; e < 4; ++e) { const int idx = tid + 512 * e, tt = idx >> 6, cc = idx & 63; O[(tok0 + (size_t)(ch - 1) * SC_T + tt) * GW + ch0 + cc] = py[idx]; }
        }
#pragma nounroll
        for (int tt = 0; tt < SC_T; ++tt) {
            const LAS float* st = cur + tt * SC_STEP;
            const f32x4 a0 = *(const LAS f32x4*)(st + 8 * q), a1 = *(const LAS f32x4*)(st + 8 * q + 4);
            const f32x4 b0 = *(const LAS f32x4*)(st + 64 + 8 * q), b1 = *(const LAS f32x4*)(st + 64 + 8 * q + 4);
            const f32x4 k0 = *(const LAS f32x4*)(st + 128 + 8 * q), k1 = *(const LAS f32x4*)(st + 128 + 8 * q + 4);
            const f32x4 r0 = *(const LAS f32x4*)(st + 192 + 8 * q), r1 = *(const LAS f32x4*)(st + 192 + 8 * q + 4);
            const f32x4 w0 = *(const LAS f32x4*)(st + 256 + 8 * q), w1 = *(const LAS f32x4*)(st + 256 + 8 * q + 4);
            const float vi = st[320 + i];
            float sa = (S[0] * a0.x + S[1] * a0.y) + (S[2] * a0.z + S[3] * a0.w) + (S[4] * a1.x + S[5] * a1.y) + (S[6] * a1.z + S[7] * a1.w);
            sa = sum8(sa);
            S[0] = S[0] * w0.x + sa * b0.x + vi * k0.x; S[1] = S[1] * w0.y + sa * b0.y + vi * k0.y; S[2] = S[2] * w0.z + sa * b0.z + vi * k0.z; S[3] = S[3] * w0.w + sa * b0.w + vi * k0.w;
            S[4] = S[4] * w1.x + sa * b1.x + vi * k1.x; S[5] = S[5] * w1.y + sa * b1.y + vi * k1.y; S[6] = S[6] * w1.z + sa * b1.z + vi * k1.z; S[7] = S[7] * w1.w + sa * b1.w + vi * k1.w;
            float y = (S[0] * r0.x + S[1] * r0.y) + (S[2] * r0.z + S[3] * r0.w) + (S[4] * r1.x + S[5] * r1.y) + (S[6] * r1.z + S[7] * r1.w);
            y = sum8(y);
            if (q == 0) yb[tt * 64 + i] = y;
        }
        if (ch + 1 < NCH) scan_store(reg, BUF + ((ch + 1) & 1) * SC_BUF, tid);
        __syncthreads();
    }
    { LAS float* py = YB + ((NCH - 1) & 1) * (SC_T * 64);
#pragma unroll
      for (int e = 0; e < 4; ++e) { const int idx = tid + 512 * e, tt = idx >> 6, cc = idx & 63; O[(tok0 + (size_t)(NCH - 1) * SC_T + tt) * GW + ch0 + cc] = py[idx]; } }
    __syncthreads();
}

__device__ __forceinline__ void rwkv_post_unit(const unsigned char* ws, const float* lnw, const float* lnb, bf16* ycat, int unit, int tid) {
    const int t0g = unit * 64, c = tid & 255, th = tid >> 8, hd = c >> 6;
    const float* O = (const float*)(ws + WS_O); const bf16* Vb = (const bf16*)(ws + WS_V); const bf16* Gb = (const bf16*)(ws + WS_G); const float* Bon = (const float*)(ws + WS_BONUS);
    const float gw = lnw[c], gb = lnb[c];
#pragma unroll 4
    for (int i = 0; i < 32; ++i) {
        const size_t tok = (size_t)(t0g + th * 32 + i);
        const float o = O[tok * GW + c];
        const float mean = wave_sum(o) * (1.f / 64.f); const float d = o - mean; const float var = wave_sum(d * d) * (1.f / 64.f);
        float on = d * __builtin_amdgcn_rsqf(var + GN_EPS) * gw + gb;
        on += Bon[tok * NH + hd] * bf2f(Vb[tok * GW + c]);
        ycat[tok * DM + 512 + c] = (bf16)f2bf(on * bf2f(Gb[tok * GW + c]));
    }
}

constexpr int PH_PER_LAYER = 12, N_PHASES = 1 + DEPTH * PH_PER_LAYER;
__global__ void __launch_bounds__(NWAVES * 64, 2) mega_fwd(Args args) {
    extern __shared__ __attribute__((aligned(16))) unsigned char lds_raw[];
    LAS unsigned char* lds = (LAS unsigned char*)lds_raw;
    const int G = gridDim.x, bx = blockIdx.x;
    const int vcu = (G % 8 == 0) ? (bx % 8) * (G / 8) + bx / 8 : bx;
    const int NGW = G * NWAVES;
    unsigned char* ws = args.ws;
    volatile LAS unsigned* MISC = (volatile LAS unsigned*)(lds + MISC_OFF);
    for (int u = threadIdx.x; u < (LDS_BYTES - LDSCTL_OFF) / 4; u += NWAVES * 64) ((LAS unsigned*)(lds + LDSCTL_OFF))[u] = 0u;
    __syncthreads();
    XcdBarrier bar; bar.bar = (unsigned*)(ws + WS_CTL) + CW_BAR; bar.x = 0; bar.st = nullptr;
    if (MK_ONE_LAUNCH) bar = xcd_barrier_post((unsigned*)(ws + WS_CTL) + CW_BAR, MISC + 8);
    const int lo = args.ph_lo, hi = args.ph_hi;
#define IN(k) (lo <= (k) && (k) < hi)
#define SEAM(k) do { if (MK_ONE_LAUNCH && IN(k) && IN((k) + 1)) xcd_barrier(bar); } while (0)

    float* X = args.out;
    bf16* HB = (bf16*)(ws + WS_HB); bf16* PH = (bf16*)(ws + WS_PH); bf16* Y = (bf16*)(ws + WS_Y); bf16* YCAT = HB;

#pragma nounroll
    for (int p = lo; p < hi; ++p) {
        const int l = (p == 0) ? 0 : (p - 1) / PH_PER_LAYER, k = (p == 0) ? -1 : (p - 1) % PH_PER_LAYER;
        int tid = threadIdx.x; asm volatile("" : "+v"(tid));
        const int lane = tid & 63, wave = __builtin_amdgcn_readfirstlane(tid >> 6), gw = vcu * NWAVES + wave;
        if (k == 0 || k == 9) {
            pg8::Gemm g{HB, (const bf16*)(ws + (k == 0 ? WS_WGU1 : WS_WGU2)), M, 2 * DFF, DM}; pg8::StaticOrder S; S.init(M, 2 * DFF, G, bx); pg8::EpiSwiGLU E{PH, DFF};
            if (!DBG_NO_GEMM) pg8::gemm_phase<pg8::EpiSwiGLU, pg8::StaticOrder, true, true>(lds, g, S, E, tid);
        } else if (k == 1 || k == 3 || k == 7 || k == 10) {
            const bf16* A = (k == 3) ? HB : (k == 7 ? YCAT : PH);
            const size_t wo = (k == 1) ? WS_WD1 : (k == 3) ? WS_WIN : (k == 7) ? WS_WOUT : WS_WD2;
            const int N = (k == 3) ? INP : DM, K = (k == 1 || k == 10) ? DFF : DM;
            pg8::Gemm g{A, (const bf16*)(ws + wo), M, N, K}; pg8::StaticOrder S; S.init(M, N, G, bx); pg8::EpiBf16 E{(k == 3) ? PH : Y, N};
            if (!DBG_NO_GEMM) pg8::gemm_phase<pg8::EpiBf16, pg8::StaticOrder, true, true>(lds, g, S, E, tid);
        } else if (k == -1) {
            convert_weights(args, 0, lds, gw, NGW, wave, lane);
            row_phase(args.in[I_X], X, nullptr, nullptr, 0.f, args.in[I_F1PRE], HB, gw, NGW, lane);
        } else if (k == 2 || k == 8 || k == 11) {
            if (k == 11 && l + 1 < DEPTH) convert_weights(args, l + 1, lds, gw, NGW, wave, lane);
            const float* gpost = (k == 2 ? args.in[I_F1POST] : k == 8 ? args.in[I_MIXPOST] : args.in[I_F2POST]) + l * DM;
            const float* gnext = (k == 2) ? args.in[I_MIXPRE] + l * DM : (k == 8) ? args.in[I_F2PRE] + l * DM : ((l + 1 < DEPTH) ? args.in[I_F1PRE] + (l + 1) * DM : nullptr);
            row_phase(X, X, Y, gpost, k == 8 ? 1.0f : 0.5f, gnext, HB, gw, NGW, lane);
        } else if (k == 4) {
            for (int u = vcu; u < 256 + 256 + 128 + 256; u += G) {
                int ll = l; asm volatile("" : "+s"(ll)); int tid = threadIdx.x; asm volatile("" : "+v"(tid)); const int lane = tid & 63, wave = __builtin_amdgcn_readfirstlane(tid >> 6);
                if (u < 256) {
                    RwkvW RW{args.in[I_MU] + ll * 896, args.in[I_W0] + ll * GW, args.in[I_WUP] + ll * 32 * GW, args.in[I_A0] + ll * GW, args.in[I_AUP] + ll * 32 * GW, args.in[I_GUP] + ll * 64 * GW,
                             args.in[I_KK] + ll * GW, args.in[I_KA] + ll * GW, args.in[I_RK] + ll * GW};
                    if (!DBG_NO_PREP) rwkv_prep_unit(PH, RW, ws, lds, u, tid, lane); }
                else if (u < 512) { if (!DBG_NO_D) mixD_unit(PH, args.in[I_CMW] + ll * 31 * GW, args.in[I_CMB] + ll * GW, args.in[I_CMLNW] + ll * GW, args.in[I_CMLNB] + ll * GW, YCAT, lds, u - 256, tid, wave, lane); }
                else if (u < 640) { if (!DBG_NO_B) mixB_unit(PH, args.in[I_SGLNW] + ll * GW, args.in[I_SGLNB] + ll * GW, args.in[I_SGW] + (size_t)ll * NH * 128 * 128, args.in[I_SGB] + ll * NH * 128, YCAT, lds, u - 512, tid, wave, lane); }
                else mixA_unit(PH, args.in[I_SCW] + ll * 3 * GW, YCAT, u - 640, tid);
            }
        } else if (k == 5) {
            for (int u = vcu; u < BATCH * NH; u += G) { if (!DBG_NO_SCAN) scan_unit(ws, lds, u, tid); }
        } else {
            for (int u = vcu; u < M / 64; u += G) rwkv_post_unit(ws, args.in[I_RLNW] + l * GW, args.in[I_RLNB] + l * GW, YCAT, u, tid);
        }
        if (MK_ONE_LAUNCH && p + 1 < hi) xcd_barrier(bar);
    }
#undef IN
#undef SEAM
}

extern "C" void kernel_launch(void* const* d_in, const int* in_sizes, int n_in, void* d_out, int out_size, void* d_ws, size_t ws_size, hipStream_t stream) {
    static int grid = 0;
    if (grid == 0) {
        if (n_in != N_IN || in_sizes[0] != M * DM || out_size != M * DM || ws_size < WS_END) { fprintf(stderr, "kernel_launch: unexpected shapes (n_in %d, in0 %d, out %d, ws %zu)\n", n_in, n_in > 0 ? in_sizes[0] : -1, out_size, ws_size); grid = -1; return; }
        int dev = 0, cus = 0, per_cu = 0;
        if (hipGetDevice(&dev) != hipSuccess || hipDeviceGetAttribute(&cus, hipDeviceAttributeMultiprocessorCount, dev) != hipSuccess) { grid = -1; return; }
        if (hipFuncSetAttribute((const void*)mega_fwd, hipFuncAttributeMaxDynamicSharedMemorySize, LDS_BYTES) != hipSuccess) { fprintf(stderr, "kernel_launch: hipFuncSetAttribute failed\n"); grid = -1; return; }
        if (hipOccupancyMaxActiveBlocksPerMultiprocessor(&per_cu, (const void*)mega_fwd, NWAVES * 64, LDS_BYTES) != hipSuccess || per_cu < 1) { fprintf(stderr, "kernel_launch: occupancy query says %d blocks per CU\n", per_cu); (void)hipGetLastError(); grid = -1; return; }
        grid = cus;
    }
    if (grid < 0) return;
    (void)hipMemsetAsync((char*)d_ws + WS_CTL, 0, CTL_ZERO_BYTES, stream);
    Args a{};
    for (int i = 0; i < N_IN; ++i) a.in[i] = (const float*)d_in[i];
    a.out = (float*)d_out; a.ws = (unsigned char*)d_ws;
#if MK_ONE_LAUNCH
    a.ph_lo = 0; a.ph_hi = N_PHASES;
    void* kargs[] = {&a};
    hipError_t e = hipLaunchCooperativeKernel((const void*)mega_fwd, dim3(grid), dim3(NWAVES * 64), kargs, LDS_BYTES, stream);
    if (e != hipSuccess) fprintf(stderr, "kernel_launch: cooperative launch failed: %s (grid %d)\n", hipGetErrorString(e), grid);
#else
    for (int p = 0; p < N_PHASES; ++p) { a.ph_lo = p; a.ph_hi = p + 1; hipLaunchKernelGGL(mega_fwd, dim3(grid), dim3(NWAVES * 64), LDS_BYTES, stream, a); }
#endif
}
```

```cpp
#include <hip/hip_runtime.h>
#include <cstdio>
#include <cstdint>

#ifndef DBG_NO_PREP
#define DBG_NO_PREP 0
#endif
#ifndef DBG_NO_D
#define DBG_NO_D 0
#endif
#ifndef DBG_NO_B
#define DBG_NO_B 0
#endif
#ifndef DBG_NO_SCAN
#define DBG_NO_SCAN 0
#endif
#ifndef DBG_NO_GEMM
#define DBG_NO_GEMM 0
#endif
#ifndef MK_ONE_LAUNCH
#define MK_ONE_LAUNCH 1
#endif

namespace pg8 {
#define PG8_LAS __attribute__((address_space(3)))
typedef unsigned short bf16_t;
typedef short bf16x8 __attribute__((ext_vector_type(8)));
typedef float f32x4 __attribute__((ext_vector_type(4)));
typedef unsigned u32x4 __attribute__((ext_vector_type(4)));
constexpr int BM = 256, BK = 64, HALF = 128, HTB = HALF * BK * 2, STAGE_BYTES = 8 * HTB, NXCD = 8, WGM = 8;

__host__ __device__ __forceinline__ int lds_byte(int r, int c) { const int st = (r >> 4) * 2 + (c >> 5), rr = r & 15, cc = c & 31, ob = rr * 64 + cc * 2; return st * 1024 + (ob ^ (((ob >> 9) & 1) << 5)); }
__host__ __device__ __forceinline__ void stage_rc(int b, int& R, int& C) { const int st = b / 1024, sb = b % 1024, swz = sb ^ (((sb >> 9) & 1) << 5); R = (st >> 1) * 16 + swz / 64; C = (st & 1) * 32 + (swz % 64) / 2; }
__host__ __device__ __forceinline__ int perm32(int rho) { const int n = rho >> 4, i = rho & 15; return 8 * (i >> 2) + 4 * n + (i & 3); }

struct Unit { int pm, pn; };
struct Gemm { const bf16_t* A; const bf16_t* Bt; int M, N, K; };

struct StaticOrder {
    int nM, nN, nwg, G, c;
    __host__ __device__ void init(int M, int N, int G_, int c_) { nM = M / BM; nN = N / BM; nwg = nM * nN; G = G_; c = c_; }
    __host__ __device__ bool next(int i, Unit& u) const {
        const long L = (long)i * G + c; if (L >= nwg) return false;
        int wgid = (int)L; { const int q = nwg / NXCD, r = nwg % NXCD, xcd = wgid % NXCD, off = wgid / NXCD; wgid = (xcd < r ? xcd * (q + 1) : r * (q + 1) + (xcd - r) * q) + off; }
        const int nig = WGM * nN, gid = wgid / nig, fm = gid * WGM, gsz = (nM - fm) < WGM ? (nM - fm) : WGM;
        u.pm = fm + ((wgid % nig) % gsz); u.pn = (wgid % nig) / gsz; return true;
    }
    __device__ __forceinline__ void a_ready(const Unit&) const {}
    __device__ __forceinline__ void done(const Unit&) const {}
};

__device__ __forceinline__ unsigned cvt_pk_bf16(float lo, float hi) { unsigned r; asm volatile("v_cvt_pk_bf16_f32 %0, %1, %2" : "=v"(r) : "v"(lo), "v"(hi)); return r; }

struct EpiBf16 {
    static constexpr bool PERM = true, AFTER_DRAIN = false;
    bf16_t* O; int ldc;
    __device__ __forceinline__ void operator()(const f32x4 (&acc)[2][2][4][2], const Unit& u, int wr, int wc, int fr, int fq) const {
        const int row0 = u.pm * BM + wr * 64 + fr; const int col0 = u.pn * BM + wc * 32 + 8 * fq;
#pragma unroll
        for (int ai = 0; ai < 2; ++ai)
#pragma unroll
            for (int m = 0; m < 4; ++m) { bf16_t* rowp = O + (size_t)(row0 + ai * HALF + m * 16) * ldc + col0;
#pragma unroll
                for (int bj = 0; bj < 2; ++bj) { const f32x4 v0 = acc[ai][bj][m][0], v1 = acc[ai][bj][m][1];
                    u32x4 w; w.x = cvt_pk_bf16(v0[0], v0[1]); w.y = cvt_pk_bf16(v0[2], v0[3]); w.z = cvt_pk_bf16(v1[0], v1[1]); w.w = cvt_pk_bf16(v1[2], v1[3]);
                    *(u32x4*)(rowp + bj * HALF) = w; } }
    }
};
__device__ __forceinline__ float silu_f(float x) { return x * __builtin_amdgcn_rcpf(1.0f + __expf(-x)); }
struct EpiSwiGLU {
    static constexpr bool PERM = true, AFTER_DRAIN = false;
    bf16_t* O; int ldc;
    __device__ __forceinline__ void operator()(const f32x4 (&acc)[2][2][4][2], const Unit& u, int wr, int wc, int fr, int fq) const {
        const int row0 = u.pm * BM + wr * 64 + fr; const int col0 = u.pn * HALF + wc * 32 + 8 * fq;
#pragma unroll
        for (int ai = 0; ai < 2; ++ai)
#pragma unroll
            for (int m = 0; m < 4; ++m) { bf16_t* rowp = O + (size_t)(row0 + ai * HALF + m * 16) * ldc + col0;
                const f32x4 g0 = acc[ai][0][m][0], g1 = acc[ai][0][m][1], u0 = acc[ai][1][m][0], u1 = acc[ai][1][m][1];
                float h[8];
#pragma unroll
                for (int e = 0; e < 4; ++e) { h[e] = silu_f(g0[e]) * u0[e]; h[4 + e] = silu_f(g1[e]) * u1[e]; }
                u32x4 w; w.x = cvt_pk_bf16(h[0], h[1]); w.y = cvt_pk_bf16(h[2], h[3]); w.z = cvt_pk_bf16(h[4], h[5]); w.w = cvt_pk_bf16(h[6], h[7]);
                *(u32x4*)rowp = w; }
    }
};

template <class Epi, class Sched, bool ALIGN_EPI = false, bool SP2 = false>
__device__ __forceinline__ void gemm_phase(PG8_LAS unsigned char* lds, const Gemm g, const Sched& S, const Epi& E, const int tid) {
    const int wid = __builtin_amdgcn_readfirstlane(tid >> 6), lane = tid & 63, wr = wid >> 2, wc = wid & 3, fr = lane & 15, fq = lane >> 4;
    const int K = g.K, nt = K / BK;
    unsigned voffA[2], voffB[2];
#pragma unroll
    for (int i = 0; i < 2; ++i) { int R, C; stage_rc(tid * 16 + i * 8192, R, C); const int Rb = Epi::PERM ? ((R & ~31) + perm32(R & 31)) : R;
        voffA[i] = (unsigned)(R * K + C) * 2u; voffB[i] = (unsigned)(Rb * K + C) * 2u; }
    const size_t kstep = (size_t)(BK * 2);
    const size_t hstep = (size_t)HALF * K * 2;
    const size_t tstep = 2 * hstep;
    const unsigned ldsw = (unsigned)wid * 1024u;
    const int aoff = lds_byte(wr * 64 + fr, fq * 8), boff = lds_byte(wc * 32 + fr, fq * 8);
#define PG8_SA(b, h) (((b) * 2 + (h)) * HTB)
#define PG8_SB(b, h) ((4 + (b) * 2 + (h)) * HTB)
#define PG8_STAGE(bufoff, gbase, voff) do { _Pragma("unroll") for (int _i = 0; _i < 2; ++_i) \
        __builtin_amdgcn_global_load_lds((const unsigned*)((const char*)(gbase) + (voff)[_i]), (PG8_LAS unsigned*)(lds + (bufoff) + ldsw + _i * 8192), 16, 0, 0); } while (0)
#define PG8_LDA(dst, b, h) do { _Pragma("unroll") for (int m = 0; m < 4; ++m) _Pragma("unroll") for (int k = 0; k < 2; ++k) dst[m][k] = *(const PG8_LAS bf16x8*)(lds + PG8_SA(b, h) + aoff + m * 2048 + k * 1024); } while (0)
#define PG8_LDB(dst, b, h) do { _Pragma("unroll") for (int n = 0; n < 2; ++n) _Pragma("unroll") for (int k = 0; k < 2; ++k) dst[n][k] = *(const PG8_LAS bf16x8*)(lds + PG8_SB(b, h) + boff + n * 2048 + k * 1024); } while (0)
#define PG8_MMA(ai, bj, At, Bt) do { __builtin_amdgcn_s_setprio(1); _Pragma("unroll") for (int m = 0; m < 4; ++m) _Pragma("unroll") for (int n = 0; n < 2; ++n) _Pragma("unroll") for (int k = 0; k < 2; ++k) \
        acc[ai][bj][m][n] = __builtin_amdgcn_mfma_f32_16x16x32_bf16(Bt[n][k], At[m][k], acc[ai][bj][m][n], 0, 0, 0); __builtin_amdgcn_s_setprio(0); } while (0)
#define PG8_WAIT_V(n) asm volatile("s_waitcnt vmcnt(" #n ")" ::: "memory")
#define PG8_WAIT_L(n) asm volatile("s_waitcnt lgkmcnt(" #n ")" ::: "memory")
#define PG8_BAR __builtin_amdgcn_s_barrier()
#define PG8_SCHED __builtin_amdgcn_sched_barrier(0)
    Unit cur, nxt; int ui = 0;
    if (!S.next(0, cur)) return;
    f32x4 acc[2][2][4][2];
#pragma unroll
    for (int a = 0; a < 2; ++a)
#pragma unroll
        for (int b = 0; b < 2; ++b)
#pragma unroll
            for (int m = 0; m < 4; ++m)
#pragma unroll
                for (int n = 0; n < 2; ++n) acc[a][b][m][n] = (f32x4){0.f, 0.f, 0.f, 0.f};
    bf16x8 At[4][2], B0[2][2], B1[2][2];
    const char* cA = (const char*)g.A + (size_t)cur.pm * tstep; const char* cB = (const char*)g.Bt + (size_t)cur.pn * tstep;
    S.a_ready(cur);
    if constexpr (SP2) {
        PG8_STAGE(PG8_SB(0, 0), cB, voffB); PG8_STAGE(PG8_SB(0, 1), cB + hstep, voffB); PG8_STAGE(PG8_SA(0, 0), cA, voffA); PG8_STAGE(PG8_SA(0, 1), cA + hstep, voffA);
        if (wr == 1) PG8_BAR;
        PG8_WAIT_V(2); PG8_BAR;
        PG8_STAGE(PG8_SB(1, 0), cB + kstep, voffB); PG8_STAGE(PG8_SA(1, 0), cA + kstep, voffA); PG8_STAGE(PG8_SB(1, 1), cB + hstep + kstep, voffB);
        PG8_WAIT_V(6); PG8_BAR;
    } else {
        PG8_STAGE(PG8_SB(0, 0), cB, voffB); PG8_STAGE(PG8_SA(0, 0), cA, voffA); PG8_STAGE(PG8_SB(0, 1), cB + hstep, voffB); PG8_STAGE(PG8_SA(0, 1), cA + hstep, voffA);
        if (wr == 1) PG8_BAR;
        PG8_WAIT_V(4); PG8_BAR;
        PG8_STAGE(PG8_SB(1, 0), cB + kstep, voffB); PG8_STAGE(PG8_SA(1, 0), cA + kstep, voffA); PG8_STAGE(PG8_SB(1, 1), cB + hstep + kstep, voffB);
        PG8_WAIT_V(6); PG8_BAR;
    }
    for (;;) {
        const bool has_next = S.next(ui + 1, nxt);
        const char* nA = has_next ? (const char*)g.A + (size_t)nxt.pm * tstep : cA; const char* nB = has_next ? (const char*)g.Bt + (size_t)nxt.pn * tstep : cB;
        for (int t = 0; t < nt; t += 2) {
            const bool last = (t == nt - 2);
            const char* a1 = cA + (size_t)(t + 1) * kstep;
            const char* a2 = last ? nA : cA + (size_t)(t + 2) * kstep; const char* b2 = last ? nB : cB + (size_t)(t + 2) * kstep;
            const char* a3 = a2 + kstep; const char* b3 = b2 + kstep;
            if (last && has_next) S.a_ready(nxt);
            if constexpr (SP2) {
            PG8_LDB(B0, 0, 0); PG8_LDB(B1, 0, 1); PG8_SCHED; PG8_LDA(At, 0, 0); PG8_STAGE(PG8_SA(1, 1), a1 + hstep, voffA);
            PG8_WAIT_V(8); PG8_WAIT_L(0); PG8_BAR; PG8_MMA(0, 0, At, B0); PG8_MMA(0, 1, At, B1); PG8_BAR; PG8_SCHED;
            PG8_LDA(At, 0, 1); PG8_STAGE(PG8_SB(0, 0), b2, voffB); PG8_STAGE(PG8_SB(0, 1), b2 + hstep, voffB); PG8_STAGE(PG8_SA(0, 0), a2, voffA);
            PG8_WAIT_V(8); PG8_WAIT_L(0); PG8_BAR; PG8_MMA(1, 0, At, B0); PG8_MMA(1, 1, At, B1); PG8_BAR; PG8_SCHED;
            PG8_LDB(B0, 1, 0); PG8_LDB(B1, 1, 1); PG8_SCHED; PG8_LDA(At, 1, 0); PG8_STAGE(PG8_SA(0, 1), a2 + hstep, voffA);
            PG8_WAIT_V(8); PG8_WAIT_L(0); PG8_BAR; PG8_MMA(0, 0, At, B0); PG8_MMA(0, 1, At, B1); PG8_BAR; PG8_SCHED;
            PG8_LDA(At, 1, 1); PG8_STAGE(PG8_SB(1, 0), b3, voffB); PG8_STAGE(PG8_SB(1, 1), b3 + hstep, voffB); PG8_STAGE(PG8_SA(1, 0), a3, voffA);
            PG8_WAIT_V(8); PG8_WAIT_L(0); PG8_BAR; PG8_MMA(1, 0, At, B0); PG8_MMA(1, 1, At, B1); PG8_BAR; PG8_SCHED;
            } else {
            PG8_LDB(B0, 0, 0); PG8_SCHED; PG8_LDA(At, 0, 0); PG8_STAGE(PG8_SA(1, 1), a1 + hstep, voffA);
            PG8_WAIT_L(8); PG8_BAR; PG8_WAIT_L(0); PG8_MMA(0, 0, At, B0); PG8_BAR; PG8_SCHED;
            PG8_LDB(B1, 0, 1); PG8_STAGE(PG8_SB(0, 0), b2, voffB);
            PG8_BAR; PG8_WAIT_L(0); PG8_MMA(0, 1, At, B1); PG8_BAR;
            PG8_LDA(At, 0, 1); PG8_STAGE(PG8_SA(0, 0), a2, voffA);
            PG8_BAR; PG8_WAIT_L(0); PG8_MMA(1, 0, At, B0); PG8_BAR; PG8_SCHED;
            PG8_STAGE(PG8_SB(0, 1), b2 + hstep, voffB);
            PG8_WAIT_V(6); PG8_BAR; PG8_MMA(1, 1, At, B1); PG8_BAR;
            PG8_LDB(B0, 1, 0); PG8_SCHED; PG8_LDA(At, 1, 0); PG8_STAGE(PG8_SA(0, 1), a2 + hstep, voffA);
            PG8_WAIT_L(8); PG8_BAR; PG8_WAIT_L(0); PG8_MMA(0, 0, At, B0); PG8_BAR; PG8_SCHED;
            PG8_LDB(B1, 1, 1); PG8_STAGE(PG8_SB(1, 0), b3, voffB);
            PG8_BAR; PG8_WAIT_L(0); PG8_MMA(0, 1, At, B1); PG8_BAR;
            PG8_LDA(At, 1, 1); PG8_STAGE(PG8_SA(1, 0), a3, voffA);
            PG8_BAR; PG8_WAIT_L(0); PG8_MMA(1, 0, At, B0); PG8_BAR; PG8_SCHED;
            PG8_STAGE(PG8_SB(1, 1), b3 + hstep, voffB);
            PG8_WAIT_V(6); PG8_BAR; PG8_MMA(1, 1, At, B1); PG8_BAR;
            }
        }
        if constexpr (ALIGN_EPI) { if (wr == 0) PG8_BAR; }
        if constexpr (!Epi::AFTER_DRAIN) { E(acc, cur, wr, wc, fr, fq); S.done(cur); }
        if (!has_next) break;
#pragma unroll
        for (int a = 0; a < 2; ++a)
#pragma unroll
            for (int b = 0; b < 2; ++b)
#pragma unroll
                for (int m = 0; m < 4; ++m)
#pragma unroll
                    for (int n = 0; n < 2; ++n) acc[a][b][m][n] = (f32x4){0.f, 0.f, 0.f, 0.f};
        cur = nxt; cA = nA; cB = nB; ++ui;
        if constexpr (ALIGN_EPI) { if (wr == 1) PG8_BAR; }
    }
    PG8_WAIT_V(0);
    if constexpr (!ALIGN_EPI) { if (wr == 0) PG8_BAR; }
    PG8_BAR;
#undef PG8_SA
#undef PG8_SB
#undef PG8_STAGE
#undef PG8_LDA
#undef PG8_LDB
#undef PG8_MMA
#undef PG8_WAIT_V
#undef PG8_WAIT_L
#undef PG8_BAR
#undef PG8_SCHED
}
}

constexpr int NWAVES = 8;
constexpr int BATCH = 8, SEQ = 2048, DM = 1024, M = BATCH * SEQ, DFF = 2816, DEPTH = 2;
constexpr int GW = 256, NH = 4, HD = 64;
constexpr int INC = 2688, INP = 2816;
constexpr int CA = 0, CB = 768, CC = 1280, CD = 2176;
constexpr float RMS_EPS = 1e-6f, LN_EPS = 1e-5f, GN_EPS = 1e-5f * 64.f;

enum { I_X = 0, I_F1PRE, I_F1G, I_F1U, I_F1D, I_F1POST, I_MIXPRE, I_WIN, I_SCW, I_SGLNW, I_SGLNB, I_SGW, I_SGB, I_MU, I_W0, I_WUP, I_A0, I_AUP, I_GUP, I_KK, I_KA, I_RK,
       I_RLNW, I_RLNB, I_CMW, I_CMB, I_CMLNW, I_CMLNB, I_WOUT, I_MIXPOST, I_F2PRE, I_F2G, I_F2U, I_F2D, I_F2POST, N_IN };

constexpr size_t MiB = 1u << 20;
constexpr size_t WS_CTL = 0, CTL_ZERO_BYTES = 1 * MiB;
constexpr size_t WS_WGU1 = 1 * MiB;
constexpr size_t WS_WD1 = 12 * MiB;
constexpr size_t WS_WIN = WS_WD1 + 5 * MiB + MiB / 2;
constexpr size_t WS_WOUT = 23 * MiB;
constexpr size_t WS_WGU2 = 25 * MiB;
constexpr size_t WS_WD2 = 36 * MiB;
constexpr size_t WS_PH = 42 * MiB;
constexpr size_t WS_HB = 130 * MiB;
constexpr size_t WS_Y = 162 * MiB;
constexpr size_t WS_G = WS_Y, WS_V = WS_Y + 8 * MiB, WS_BONUS = WS_Y + 16 * MiB;
constexpr size_t WS_REC = 194 * MiB;
constexpr size_t WS_GY = 219 * MiB;
constexpr size_t WS_HYV = 227 * MiB;
constexpr size_t WS_ST0 = 243 * MiB;
constexpr size_t WS_END = 251 * MiB;
constexpr int CW_BAR = 4096;

constexpr int RING_BYTES = 131072;
constexpr int LDSCTL_OFF = 145408, MISC_OFF = LDSCTL_OFF + 320;
constexpr int LDS_BYTES = 147456;

#define GAS __attribute__((address_space(1)))
#define LAS __attribute__((address_space(3)))
typedef unsigned short bf16;
typedef unsigned v4u __attribute__((ext_vector_type(4)));
typedef unsigned v2u __attribute__((ext_vector_type(2)));
typedef float f32x4 __attribute__((ext_vector_type(4)));
typedef float f32x16 __attribute__((ext_vector_type(16)));
typedef short bf16x8 __attribute__((ext_vector_type(8)));
typedef GAS unsigned gu32;
#define LDS_WAIT() asm volatile("s_waitcnt lgkmcnt(0)" ::: "memory")
#define VM_WAIT() asm volatile("s_waitcnt vmcnt(0)" ::: "memory")
__device__ __forceinline__ unsigned f2bf(float f) { unsigned u = __builtin_bit_cast(unsigned, f); return (u + 0x7fffu + ((u >> 16) & 1u)) >> 16; }
__device__ __forceinline__ unsigned pk2(float lo, float hi) { return f2bf(lo) | (f2bf(hi) << 16); }
__device__ __forceinline__ float bf2f(unsigned h) { return __builtin_bit_cast(float, h << 16); }
__device__ __forceinline__ float bflo(unsigned w) { return __builtin_bit_cast(float, w << 16); }
__device__ __forceinline__ float bfhi(unsigned w) { return __builtin_bit_cast(float, w & 0xffff0000u); }
__device__ __forceinline__ float sigmoid_f(float x) { return __builtin_amdgcn_rcpf(1.0f + __expf(-x)); }

#define XB_TMO      128
#define XB_XCNT(j)  (256  + 64 * (j))
#define XB_XSUB(j)  (1280 + 64 * (j))
#define XB_XGEN(j)  (2304 + 64 * (j))
#define XB_TOP      3328
#define XB_TOPGEN   3392
#define XCD_BAR_WORDS 3456
#define XB_SPIN_CAP (1u << 20)
__device__ __forceinline__ unsigned xb_ld(unsigned* p)              { return __hip_atomic_load(p, __ATOMIC_RELAXED, __HIP_MEMORY_SCOPE_AGENT); }
__device__ __forceinline__ unsigned xb_add(unsigned* p, unsigned v) { return __hip_atomic_fetch_add(p, v, __ATOMIC_RELAXED, __HIP_MEMORY_SCOPE_AGENT); }
__device__ __forceinline__ unsigned xb_xcc_id() { return (unsigned)__builtin_amdgcn_s_getreg((3 << 11) | 20) & 0xFu; }
#define XB_SPIN(cond, bar) do { unsigned _sp = 0; while (cond) { __builtin_amdgcn_s_sleep(1); \
    if ((++_sp & 255u) == 0u) { if (xb_ld(&(bar)[XB_TMO])) break; if (_sp > XB_SPIN_CAP) { atomicAdd(&(bar)[XB_TMO], 1u); break; } } } } while (0)
struct XcdBarrier { unsigned* bar; unsigned x; volatile LAS unsigned* st; };
__device__ __forceinline__ XcdBarrier xcd_barrier_post(unsigned* bar, volatile LAS unsigned* st) {
    XcdBarrier b; b.bar = bar; b.x = xb_xcc_id(); b.st = st;
    if (threadIdx.x == 0) (void)xb_add(&bar[XB_XCNT(b.x)], 1u);
    return b;
}
__device__ __forceinline__ void xcd_barrier_complete(unsigned* bar, unsigned x, unsigned& nloc, unsigned& nx) {
    const unsigned G = gridDim.x * gridDim.y * gridDim.z;
    unsigned sum, cnt, mine, sp = 0u;
    for (;;) {
        sum = 0u; cnt = 0u; mine = 0u;
#pragma unroll
        for (unsigned j = 0; j < 16; ++j) { const unsigned c = xb_ld(&bar[XB_XCNT(j)]); sum += c; cnt += (c > 0u) ? 1u : 0u; mine = (j == x) ? c : mine; }
        if (sum == G) break;
        __builtin_amdgcn_s_sleep(1);
        if ((++sp & 255u) == 0u) { if (xb_ld(&bar[XB_TMO])) break; if (sp > XB_SPIN_CAP) { atomicAdd(&bar[XB_TMO], 1u); break; } }
    }
    nloc = mine > 0u ? mine : 1u; nx = cnt > 0u ? cnt : 1u;
}
__device__ __forceinline__ void xcd_barrier(const XcdBarrier& b) {
    asm volatile("s_waitcnt vmcnt(0)" ::: "memory");
    __syncthreads();
    if (threadIdx.x == 0) {
        unsigned* bar = b.bar;
        __builtin_amdgcn_s_waitcnt(0);
        unsigned nloc = b.st[0], nx = b.st[1];
        if (nloc == 0u) { xcd_barrier_complete(bar, b.x, nloc, nx); b.st[0] = nloc; b.st[1] = nx; }
        const unsigned old = xb_add(&bar[XB_XSUB(b.x)], 1u);
        const unsigned gen = old / nloc;
        if (old + 1u == (gen + 1u) * nloc) {
            __builtin_amdgcn_fence(__ATOMIC_RELEASE, "agent");
            asm volatile("s_waitcnt vmcnt(0)" ::: "memory");
            const unsigned og = xb_add(&bar[XB_TOP], 1u);
            const unsigned tg = og / nx;
            if (og + 1u == (tg + 1u) * nx) xb_add(&bar[XB_TOPGEN], 1u);
            else XB_SPIN(xb_ld(&bar[XB_TOPGEN]) == tg, bar);
            __builtin_amdgcn_fence(__ATOMIC_ACQUIRE, "agent");
            xb_add(&bar[XB_XGEN(b.x)], 1u);
            asm volatile("s_waitcnt vmcnt(0)" ::: "memory");
        } else {
            XB_SPIN(xb_ld(&bar[XB_XGEN(b.x)]) == gen, bar);
            __builtin_amdgcn_fence(__ATOMIC_ACQUIRE, "agent");
            asm volatile("s_waitcnt vmcnt(0)" ::: "memory");
        }
    }
    __syncthreads();
}

__device__ __forceinline__ float wave_sum(float v) {
#pragma unroll
    for (int o = 1; o < 64; o <<= 1) v += __shfl_xor(v, o);
    return v;
}
__device__ __forceinline__ float sum8(float v) {
    v += __builtin_bit_cast(float, __builtin_amdgcn_update_dpp(0, __builtin_bit_cast(int, v), 0xB1, 0xf, 0xf, true));
    v += __builtin_bit_cast(float, __builtin_amdgcn_update_dpp(0, __builtin_bit_cast(int, v), 0x4E, 0xf, 0xf, true));
    v += __builtin_bit_cast(float, __builtin_amdgcn_update_dpp(0, __builtin_bit_cast(int, v), 0x141, 0xf, 0xf, true));
    return v;
}

struct Ctx {
    LAS unsigned char* lds;
    int tid, lane, wave, vcu, G;
    const float* const* in;
};

__device__ __forceinline__ void transpose_item(const float* W, int K, int N, bf16* WT, int row_off, LAS float* scr, int item, int lane) {
    const int nblk = N / 32, kb = item / nblk, nb = item % nblk, k0 = 64 * kb, n0 = 32 * nb;
#pragma unroll 8
    for (int i = 0; i < 32; ++i) { const int kk = 2 * i + (lane >> 5); scr[kk * 33 + (lane & 31)] = W[(size_t)(k0 + kk) * N + n0 + (lane & 31)]; }
    LDS_WAIT(); asm volatile("" ::: "memory");
    const int c = lane & 7;
#pragma unroll
    for (int j = 0; j < 4; ++j) { const int n = (lane >> 3) + 8 * j; const LAS float* s = scr + (8 * c) * 33 + n;
        v4u o; o.x = pk2(s[0 * 33], s[1 * 33]); o.y = pk2(s[2 * 33], s[3 * 33]); o.z = pk2(s[4 * 33], s[5 * 33]); o.w = pk2(s[6 * 33], s[7 * 33]);
        *(v4u*)(WT + (size_t)(row_off + n0 + n) * K + k0 + 8 * c) = o; }
    LDS_WAIT(); asm volatile("" ::: "memory");
}
__device__ __forceinline__ void transpose_item_gu(const float* W, bf16* WT, int up, LAS float* scr, int item, int lane) {
    const int nblk = DFF / 32, nb = item % nblk, n0 = 32 * nb;
    const int dest0 = (n0 / 128) * 256 + (n0 % 128) + up * 128;
    transpose_item(W, DM, DFF, WT, dest0 - n0, scr, item, lane);
}

struct Args { const float* in[N_IN]; float* out; unsigned char* ws; int ph_lo, ph_hi; };

__device__ __forceinline__ void convert_weights(const Args& a, int l, LAS unsigned char* lds, int gw, int NGW, int wave, int lane) {
    LAS float* scr = (LAS float*)(lds + wave * 16384);
    constexpr int I_GU = (DM / 64) * (DFF / 32), I_DN = (DFF / 64) * (DM / 32), I_IN = (DM / 64) * (INC / 32), I_OUT = (DM / 64) * (DM / 32);
    constexpr int NITEMS = 4 * I_GU + 2 * I_DN + I_IN + I_OUT;
    unsigned char* ws = a.ws;
    const size_t oGU = (size_t)l * DM * DFF, oIN = (size_t)l * DM * INC, oOUT = (size_t)l * DM * DM;
    for (int it = gw; it < NITEMS; it += NGW) {
        int r = it;
        if (r < I_GU) { transpose_item_gu(a.in[I_F1G] + oGU, (bf16*)(ws + WS_WGU1), 0, scr, r, lane); continue; } r -= I_GU;
        if (r < I_GU) { transpose_item_gu(a.in[I_F1U] + oGU, (bf16*)(ws + WS_WGU1), 1, scr, r, lane); continue; } r -= I_GU;
        if (r < I_GU) { transpose_item_gu(a.in[I_F2G] + oGU, (bf16*)(ws + WS_WGU2), 0, scr, r, lane); continue; } r -= I_GU;
        if (r < I_GU) { transpose_item_gu(a.in[I_F2U] + oGU, (bf16*)(ws + WS_WGU2), 1, scr, r, lane); continue; } r -= I_GU;
        if (r < I_DN) { transpose_item(a.in[I_F1D] + oGU, DFF, DM, (bf16*)(ws + WS_WD1), 0, scr, r, lane); continue; } r -= I_DN;
        if (r < I_DN) { transpose_item(a.in[I_F2D] + oGU, DFF, DM, (bf16*)(ws + WS_WD2), 0, scr, r, lane); continue; } r -= I_DN;
        if (r < I_IN) { transpose_item(a.in[I_WIN] + oIN, DM, INC, (bf16*)(ws + WS_WIN), 0, scr, r, lane); continue; } r -= I_IN;
        transpose_item(a.in[I_WOUT] + oOUT, DM, DM, (bf16*)(ws + WS_WOUT), 0, scr, r, lane);
    }
    { v4u* z = (v4u*)((bf16*)(ws + WS_WIN) + (size_t)INC * DM); const int n16 = (INP - INC) * DM * 2 / 16;
      for (int i = gw * 64 + lane; i < n16; i += NGW * 64) z[i] = (v4u){0u, 0u, 0u, 0u}; }
}

__device__ __forceinline__ void row_phase(const float* xsrc, float* xdst, const bf16* y, const float* gpost, float scale, const float* gnext, bf16* hb, int gw, int NGW, int lane) {
    for (int m = gw; m < M; m += NGW) {
        const f32x4* xr = (const f32x4*)(xsrc + (size_t)m * DM) + lane;
        f32x4 v[4];
#pragma unroll
        for (int j = 0; j < 4; ++j) v[j] = xr[64 * j];
        if (y) {
            const v2u* yr = (const v2u*)(y + (size_t)m * DM) + lane; f32x4 yv[4]; float s = 0.f;
#pragma unroll
            for (int j = 0; j < 4; ++j) { const v2u w = yr[64 * j]; yv[j] = (f32x4){bflo(w.x), bfhi(w.x), bflo(w.y), bfhi(w.y)}; s += (yv[j].x * yv[j].x + yv[j].y * yv[j].y) + (yv[j].z * yv[j].z + yv[j].w * yv[j].w); }
            const float rs = scale * __builtin_amdgcn_rsqf(wave_sum(s) * (1.f / DM) + RMS_EPS);
#pragma unroll
            for (int j = 0; j < 4; ++j) { const f32x4 g = ((const f32x4*)gpost)[64 * j + lane]; v[j] = v[j] + (yv[j] * rs) * g; }
        }
        if (y || xsrc != xdst) { f32x4* xo = (f32x4*)(xdst + (size_t)m * DM) + lane;
#pragma unroll
            for (int j = 0; j < 4; ++j) xo[64 * j] = v[j]; }
        if (gnext) {
            float s2 = 0.f;
#pragma unroll
            for (int j = 0; j < 4; ++j) s2 += (v[j].x * v[j].x + v[j].y * v[j].y) + (v[j].z * v[j].z + v[j].w * v[j].w);
            const float rs2 = __builtin_amdgcn_rsqf(wave_sum(s2) * (1.f / DM) + RMS_EPS);
            v2u* ho = (v2u*)(hb + (size_t)m * DM) + lane;
#pragma unroll
            for (int j = 0; j < 4; ++j) { const f32x4 g = ((const f32x4*)gnext)[64 * j + lane]; const f32x4 h = (v[j] * rs2) * g; v2u w; w.x = pk2(h.x, h.y); w.y = pk2(h.z, h.w); ho[64 * j] = w; }
        }
    }
}

__device__ __forceinline__ void mixA_unit(const bf16* P, const float* scw, bf16* ycat, int unit, int tid) {
    const int b = unit >> 5, t0 = (unit & 31) * 64;
    const int cp = tid & 127, tg = tid >> 7, c = 2 * cp;
    const float w0a = scw[c], w0b = scw[c + 1], w1a = scw[GW + c], w1b = scw[GW + c + 1], w2a = scw[2 * GW + c], w2b = scw[2 * GW + c + 1];
    const int ts = t0 + tg * 16;
    float g2a = 0.f, g2b = 0.f, g1a = 0.f, g1b = 0.f;
    const bf16* prow = P + (size_t)(b * SEQ) * INP;
    if (ts >= 2) { const unsigned gc = *(const unsigned*)(prow + (size_t)(ts - 2) * INP + CA + 256 + c), xa = *(const unsigned*)(prow + (size_t)(ts - 2) * INP + CA + 512 + c); g2a = bflo(gc) * bflo(xa); g2b = bfhi(gc) * bfhi(xa); }
    if (ts >= 1) { const unsigned gc = *(const unsigned*)(prow + (size_t)(ts - 1) * INP + CA + 256 + c), xa = *(const unsigned*)(prow + (size_t)(ts - 1) * INP + CA + 512 + c); g1a = bflo(gc) * bflo(xa); g1b = bfhi(gc) * bfhi(xa); }
#pragma unroll 4
    for (int i = 0; i < 16; ++i) {
        const bf16* pr = prow + (size_t)(ts + i) * INP + CA;
        const unsigned gb = *(const unsigned*)(pr + c), gc = *(const unsigned*)(pr + 256 + c), xa = *(const unsigned*)(pr + 512 + c);
        const float g0a = bflo(gc) * bflo(xa), g0b = bfhi(gc) * bfhi(xa);
        const float ya = bflo(gb) * (w0a * g2a + w1a * g1a + w2a * g0a), yb = bfhi(gb) * (w0b * g2b + w1b * g1b + w2b * g0b);
        *(unsigned*)(ycat + (size_t)(b * SEQ + ts + i) * DM + c) = pk2(ya, yb);
        g2a = g1a; g2b = g1b; g1a = g0a; g1b = g0b;
    }
}

__device__ __forceinline__ void mixD_unit(const bf16* P, const float* cw, const float* cb, const float* lnw, const float* lnb, bf16* ycat, LAS unsigned char* lds, int unit, int tid, int wave, int lane) {
    const int b = unit >> 5, t0 = (unit & 31) * 64;
    LAS float* L = (LAS float*)lds;
    const bf16* prow = P + (size_t)(b * SEQ) * INP + CD;
    for (int idx = tid; idx < 94 * 128; idx += 512) {
        const int s = idx >> 7, cp = idx & 127, tok = t0 - 30 + s; float ga = 0.f, gb = 0.f;
        if (tok >= 0) { const unsigned z1 = *(const unsigned*)(prow + (size_t)tok * INP + 2 * cp), z2 = *(const unsigned*)(prow + (size_t)tok * INP + 256 + 2 * cp);
            ga = bflo(z1) * sigmoid_f(bflo(z2)); gb = bfhi(z1) * sigmoid_f(bfhi(z2)); }
        L[s * 256 + 2 * cp] = ga; L[s * 256 + 2 * cp + 1] = gb;
    }
    __syncthreads();
    const int c = tid & 255, tg = tid >> 8;
    float w[31];
#pragma unroll
    for (int j = 0; j < 31; ++j) w[j] = cw[j * GW + c];
    const float bias = cb[c];
    float res[32];
#pragma unroll
    for (int ps = 0; ps < 2; ++ps) {
        float acc[16];
#pragma unroll
        for (int i = 0; i < 16; ++i) acc[i] = bias;
#pragma unroll
        for (int s = 0; s < 46; ++s) {
            const float gv = L[(tg * 32 + ps * 16 + s) * 256 + c];
#pragma unroll
            for (int tt = 0; tt < 16; ++tt) { const int j = s - tt; if (j >= 0 && j <= 30) acc[tt] += w[j] * gv; }
        }
#pragma unroll
        for (int i = 0; i < 16; ++i) res[ps * 16 + i] = acc[i];
        asm volatile("" ::: "memory");
    }
    __syncthreads();
#pragma unroll
    for (int tt = 0; tt < 32; ++tt) L[(tg * 32 + tt) * 256 + c] = res[tt];
    __syncthreads();
    const f32x4 gw4 = ((const f32x4*)lnw)[lane], gb4 = ((const f32x4*)lnb)[lane];
#pragma unroll 2
    for (int i = 0; i < 8; ++i) {
        const int tt = wave * 8 + i; const f32x4 z = *(const LAS f32x4*)(L + tt * 256 + 4 * lane);
        const float mean = wave_sum((z.x + z.y) + (z.z + z.w)) * (1.f / 256.f);
        const f32x4 d = z - mean; const float var = wave_sum((d.x * d.x + d.y * d.y) + (d.z * d.z + d.w * d.w)) * (1.f / 256.f);
        const float rstd = __builtin_amdgcn_rsqf(var + LN_EPS);
        f32x4 o = (d * rstd) * gw4 + gb4; o.x = pg8::silu_f(o.x); o.y = pg8::silu_f(o.y); o.z = pg8::silu_f(o.z); o.w = pg8::silu_f(o.w);
        v2u wv; wv.x = pk2(o.x, o.y); wv.y = pk2(o.z, o.w);
        *(v2u*)(ycat + (size_t)(b * SEQ + t0 + tt) * DM + 768 + 4 * lane) = wv;
    }
    __syncthreads();
}

__device__ __forceinline__ void mixB_unit(const bf16* P, const float* lnw, const float* lnb, const float* sgw, const float* sgb, bf16* ycat, LAS unsigned char* lds, int unit, int tid, int wave, int lane) {
    const int b = unit >> 4, n = unit & 15, tok0 = b * SEQ + n * 128;
    LAS bf16* VT = (LAS bf16*)lds;
    {
        const f32x4 gw4 = ((const f32x4*)lnw)[lane], gb4 = ((const f32x4*)lnb)[lane];
#pragma unroll 4
        for (int i = 0; i < 16; ++i) {
            const int s = wave * 16 + i; const v2u w = *(const v2u*)(P + (size_t)(tok0 + s) * INP + CB + 256 + 4 * lane);
            const f32x4 v = (f32x4){bflo(w.x), bfhi(w.x), bflo(w.y), bfhi(w.y)};
            const float mean = wave_sum((v.x + v.y) + (v.z + v.w)) * (1.f / 256.f);
            const f32x4 d = v - mean; const float var = wave_sum((d.x * d.x + d.y * d.y) + (d.z * d.z + d.w * d.w)) * (1.f / 256.f);
            const float rstd = __builtin_amdgcn_rsqf(var + LN_EPS);
            const f32x4 o = (d * rstd) * gw4 + gb4;
            VT[(4 * lane + 0) * 136 + s] = (bf16)f2bf(o.x); VT[(4 * lane + 1) * 136 + s] = (bf16)f2bf(o.y);
            VT[(4 * lane + 2) * 136 + s] = (bf16)f2bf(o.z); VT[(4 * lane + 3) * 136 + s] = (bf16)f2bf(o.w);
        }
    }
    __syncthreads();
    const int h = wave >> 1, rh = wave & 1, r = lane & 31, hh = lane >> 5;
#pragma unroll
    for (int ti = 0; ti < 2; ++ti) {
        const int i = ti == 0 ? rh : 3 - rh;
        f32x16 acc0, acc1;
#pragma unroll
        for (int e = 0; e < 16; ++e) { acc0[e] = 0.f; acc1[e] = 0.f; }
        const int nks = 2 * (i + 1), t = 32 * i + r;
        const float* wrow = sgw + ((size_t)h * 128 + t) * 128;
        for (int ks = 0; ks < nks; ++ks) {
            const int s0 = 16 * ks + 8 * hh;
            const f32x4 wa = *(const f32x4*)(wrow + s0), wb = *(const f32x4*)(wrow + s0 + 4);
            float wv[8] = {wa.x, wa.y, wa.z, wa.w, wb.x, wb.y, wb.z, wb.w};
            bf16x8 A;
#pragma unroll
            for (int e = 0; e < 8; ++e) A[e] = (short)f2bf((s0 + e <= t) ? wv[e] : 0.f);
            const bf16x8 B0 = *(const LAS bf16x8*)(VT + (64 * h + r) * 136 + s0), B1 = *(const LAS bf16x8*)(VT + (64 * h + 32 + r) * 136 + s0);
            acc0 = __builtin_amdgcn_mfma_f32_32x32x16_bf16(A, B0, acc0, 0, 0, 0);
            acc1 = __builtin_amdgcn_mfma_f32_32x32x16_bf16(A, B1, acc1, 0, 0, 0);
        }
#pragma unroll
        for (int reg = 0; reg < 16; ++reg) {
            const int row = (reg & 3) + 8 * (reg >> 2) + 4 * hh, tt = 32 * i + row; const size_t tok = (size_t)(tok0 + tt);
            const float bias = sgb[h * 128 + tt];
            const int c0 = 64 * h + r;
            const float u0 = bf2f(P[tok * INP + CB + c0]), u1 = bf2f(P[tok * INP + CB + c0 + 32]);
            ycat[tok * DM + 256 + c0] = (bf16)f2bf(u0 * (acc0[reg] + bias));
            ycat[tok * DM + 256 + c0 + 32] = (bf16)f2bf(u1 * (acc1[reg] + bias));
        }
    }
    __syncthreads();
}

struct RwkvW { const float *mu, *w0, *wup, *a0, *aup, *gup, *kk, *ka, *rk; };
constexpr int XS = 72, NPS = 68;
constexpr int X_AT = 0, X_RT = 9216, X_BT = 18432, X_KT = 27648, X_VT = 36864, X_BH = 46080, X_KH = 55296, X_NP = 64512, X_NK = 81920, X_MB = 91136, X_MK = 100352, X_X2 = 109568,
              X_L = 126976, X_TOT = 143360, X_END = 145408;
constexpr int X_ZT = X_BT;
constexpr int REC_BYTES = 25600;

__device__ __forceinline__ f32x16 mm64(const LAS bf16* PA, const LAS bf16* PB, int r, int hh, f32x16 acc) {
#pragma unroll
    for (int ks = 0; ks < 4; ++ks) {
        const bf16x8 av = *(const LAS bf16x8*)(PA + r * XS + 16 * ks + 8 * hh), bv = *(const LAS bf16x8*)(PB + r * XS + 16 * ks + 8 * hh);
        acc = __builtin_amdgcn_mfma_f32_32x32x16_bf16(av, bv, acc, 0, 0, 0);
    }
    return acc;
}
__device__ __forceinline__ float quad_sum(float v) {
    v += __builtin_bit_cast(float, __builtin_amdgcn_update_dpp(0, __builtin_bit_cast(int, v), 0xB1, 0xf, 0xf, true));
    v += __builtin_bit_cast(float, __builtin_amdgcn_update_dpp(0, __builtin_bit_cast(int, v), 0x4E, 0xf, 0xf, true));
    return v;
}
__device__ __forceinline__ float sx(short v) { return __builtin_bit_cast(float, (unsigned)(unsigned short)v << 16); }
#define WG_BAR() do { asm volatile("s_waitcnt vmcnt(0) lgkmcnt(0)" ::: "memory"); __builtin_amdgcn_s_barrier(); asm volatile("" ::: "memory"); } while (0)

__device__ __forceinline__ void rwkv_chunk_unit(const bf16* P, const RwkvW& W, unsigned char* ws, LAS unsigned char* lds, int unit, int tid, int wave, int lane) {
    const int b = unit >> 5, cidx = unit & 31, t0 = cidx * 64;
    const bf16* prow = P + (size_t)(b * SEQ) * INP + CC;
    LAS bf16* Lb = (LAS bf16*)(lds + X_L);
    for (int idx = tid; idx < 64 * 128; idx += 512) {
        const int tt = idx >> 7, j = idx & 127, tok = t0 + tt;
        const float cur = bf2f(prow[(size_t)tok * INP + 768 + j]); const float prev = tok > 0 ? bf2f(prow[(size_t)(tok - 1) * INP + 768 + j]) : 0.f;
        const float xs = cur + (prev - cur) * W.mu[768 + j];
        float o; if (j < 32) o = tanhf(xs); else if (j < 64) o = xs; else o = sigmoid_f(xs);
        Lb[tt * 128 + j] = (bf16)f2bf(o);
    }
    __syncthreads();
    const int tg = wave;
    LAS bf16* PAt = (LAS bf16*)(lds + X_AT); LAS bf16* PRt = (LAS bf16*)(lds + X_RT); LAS bf16* PBt = (LAS bf16*)(lds + X_BT); LAS bf16* PKt = (LAS bf16*)(lds + X_KT);
    LAS bf16* PVT = (LAS bf16*)(lds + X_VT); LAS bf16* PBH = (LAS bf16*)(lds + X_BH); LAS bf16* PKH = (LAS bf16*)(lds + X_KH);
    LAS float* PNP = (LAS float*)(lds + X_NP); LAS bf16* PNK = (LAS bf16*)(lds + X_NK); LAS bf16* PMB = (LAS bf16*)(lds + X_MB); LAS bf16* PMK = (LAS bf16*)(lds + X_MK);
    LAS float* PX2 = (LAS float*)(lds + X_X2); LAS float* PTOT = (LAS float*)(lds + X_TOT); LAS bf16* PZT = (LAS bf16*)(lds + X_ZT);
    bf16* Vg = (bf16*)(ws + WS_V); bf16* Gg = (bf16*)(ws + WS_G); float* Bon = (float*)(ws + WS_BONUS);
#pragma nounroll
    for (int h = 0; h < NH; ++h) {
        int tidh = tid; asm volatile("" : "+v"(tidh));
        const int c = tidh & 63, r = tidh & 31, hh = (tidh >> 5) & 1;
        const int ch = 64 * h + c;
        const size_t rc = (size_t)((b * NH + h) * 32 + cidx);
        unsigned char* rec = ws + WS_REC + rc * REC_BYTES;
        const size_t tokb = (size_t)(b * SEQ + t0 + 8 * tg);
        float lw8[8];
        {
            float wup[32];
#pragma unroll
            for (int j = 0; j < 32; ++j) wup[j] = W.wup[j * GW + ch];
            const float w0 = W.w0[ch];
#pragma unroll
            for (int i = 0; i < 8; ++i) {
                const LAS bf16x8* Lr = (const LAS bf16x8*)(Lb + (8 * tg + i) * 128);
                float z0 = w0, z1 = 0.f;
#pragma unroll
                for (int q = 0; q < 4; q += 2) { const bf16x8 x = Lr[q], y = Lr[q + 1];
#pragma unroll
                    for (int e = 0; e < 8; ++e) { z0 += sx(x[e]) * wup[8 * q + e]; z1 += sx(y[e]) * wup[8 * q + 8 + e]; } }
                const float nz = -(z0 + z1); const float sp = fmaxf(nz, 0.f) + log1pf(__expf(-fabsf(nz)));
                lw8[i] = -__expf(-sp - 0.5f);
                asm volatile("" ::: "memory");
            }
        }
        float lc[8]; { float run = 0.f;
#pragma unroll
            for (int i = 0; i < 8; ++i) { run += lw8[i]; lc[i] = run; } }
        PTOT[tg * 64 + c] = lc[7];
        WG_BAR();
        float off = 0.f, ltot = 0.f;
#pragma unroll
        for (int g = 0; g < 8; ++g) { const float tv = PTOT[g * 64 + c]; ltot += tv; off += (g < tg) ? tv : 0.f; }
        if (tg == 0) ((float*)(rec + 24576))[c] = __expf(ltot);
        {
            float gup[64];
#pragma unroll
            for (int j = 0; j < 64; ++j) gup[j] = W.gup[j * GW + ch];
#pragma unroll
            for (int i = 0; i < 8; ++i) {
                const LAS bf16x8* Lr = (const LAS bf16x8*)(Lb + (8 * tg + i) * 128 + 64);
                float g0 = 0.f, g1 = 0.f;
#pragma unroll
                for (int q = 0; q < 8; q += 2) { const bf16x8 x = Lr[q], y = Lr[q + 1];
#pragma unroll
                    for (int e = 0; e < 8; ++e) { g0 += sx(x[e]) * gup[8 * q + e]; g1 += sx(y[e]) * gup[8 * q + 8 + e]; } }
                Gg[(tokb + i) * GW + ch] = (bf16)f2bf(g0 + g1);
                asm volatile("" ::: "memory");
            }
        }
        {
            float aup[32];
#pragma unroll
            for (int j = 0; j < 32; ++j) aup[j] = W.aup[j * GW + ch];
            const float mur = W.mu[ch], muk = W.mu[256 + ch], muv = W.mu[512 + ch], a0 = W.a0[ch], kkc = W.kk[ch], kac = W.ka[ch], rkc = W.rk[ch];
            const int ts = t0 + 8 * tg;
            float pr = 0.f, pk = 0.f, pv = 0.f;
            if (ts > 0) { const bf16* q = prow + (size_t)(ts - 1) * INP; pr = bf2f(q[ch]); pk = bf2f(q[256 + ch]); pv = bf2f(q[512 + ch]); }
#pragma unroll
            for (int i = 0; i < 8; ++i) {
                const bf16* q = prow + (size_t)(ts + i) * INP;
                const float cr = bf2f(q[ch]), ck = bf2f(q[256 + ch]), cv = bf2f(q[512 + ch]);
                const float rr = cr + (pr - cr) * mur, k = ck + (pk - ck) * muk, v = cv + (pv - cv) * muv;
                pr = cr; pk = ck; pv = cv;
                const LAS bf16x8* Lr = (const LAS bf16x8*)(Lb + (8 * tg + i) * 128 + 32);
                float z0 = a0, z1 = 0.f;
#pragma unroll
                for (int q2 = 0; q2 < 4; q2 += 2) { const bf16x8 x = Lr[q2], y = Lr[q2 + 1];
#pragma unroll
                    for (int e = 0; e < 8; ++e) { z0 += sx(x[e]) * aup[8 * q2 + e]; z1 += sx(y[e]) * aup[8 * q2 + 8 + e]; } }
                const float asig = sigmoid_f(z0 + z1);
                float kk = k * kkc; const float nrm = sqrtf(wave_sum(kk * kk)); kk = kk / fmaxf(nrm, 1e-12f);
                const float k2 = k * (1.f + (asig - 1.f) * kac);
                const float bon = wave_sum(rr * k2 * rkc);
                const float rq = bf2f(f2bf(rr)), kq = bf2f(f2bf(k2)), kkq = bf2f(f2bf(kk)), bq = bf2f(f2bf(kk * asig));
                const unsigned vq = f2bf(v);
                Vg[(tokb + i) * GW + ch] = (bf16)vq;
                if ((tidh & 63) == 0) Bon[(tokb + i) * NH + h] = bon;
                const int t = 8 * tg + i; const float Lt = off + lc[i], Lm = Lt - lw8[i];
                const float eL = __expf(Lt), eLm = __expf(Lm), enL = __expf(-Lt), eCL = __expf(ltot - Lt);
                PAt[t * XS + c] = (bf16)f2bf(-kkq * eLm); PRt[t * XS + c] = (bf16)f2bf(rq * eL); PBt[t * XS + c] = (bf16)f2bf(bq * enL); PKt[t * XS + c] = (bf16)f2bf(kq * enL);
                PVT[c * XS + t] = (bf16)vq; PBH[c * XS + t] = (bf16)f2bf(bq * eCL); PKH[c * XS + t] = (bf16)f2bf(kq * eCL);
                asm volatile("" ::: "memory");
            }
        }
        WG_BAR();
        {
            const int prod = wave >> 1, nt = wave & 1, t = 32 * nt + r;
            const LAS bf16* PA = (prod & 1) ? PKt : PBt; const LAS bf16* PB = (prod >> 1) ? PRt : PAt;
#pragma unroll
            for (int mt = 0; mt < 2; ++mt) {
                f32x16 acc;
#pragma unroll
                for (int e = 0; e < 16; ++e) acc[e] = 0.f;
                if (mt <= nt) acc = mm64(PA + 32 * mt * XS, PB + 32 * nt * XS, r, hh, acc);
#pragma unroll
                for (int g = 0; g < 4; ++g) {
                    const int tau0 = 32 * mt + 8 * g + 4 * hh; float vv[4];
#pragma unroll
                    for (int e = 0; e < 4; ++e) { const int tau = tau0 + e; const bool keep = (prod >= 2) ? (tau <= t) : (tau < t); vv[e] = keep ? acc[4 * g + e] : 0.f; }
                    if (prod == 0) {
#pragma unroll
                        for (int e = 0; e < 4; ++e) PNP[t * NPS + e * 16 + (8 * mt + 2 * g + hh)] = vv[e];
                    } else {
                        LAS bf16* PD = (prod == 1) ? PNK : (prod == 2) ? PMB : PMK;
                        v2u w; w.x = pk2(vv[0], vv[1]); w.y = pk2(vv[2], vv[3]); *(LAS v2u*)(PD + t * XS + tau0) = w;
                    }
                }
            }
        }
        WG_BAR();
        if (wave < 4) {
            const int mt = wave >> 1, nt = wave & 1, t = 32 * nt + r;
            f32x16 acc;
#pragma unroll
            for (int e = 0; e < 16; ++e) acc[e] = 0.f;
            acc = mm64(PVT + 32 * mt * XS, PNK + 32 * nt * XS, r, hh, acc);
#pragma unroll
            for (int g = 0; g < 4; ++g) *(LAS f32x4*)(PX2 + t * NPS + 32 * mt + 8 * g + 4 * hh) = (f32x4){acc[4 * g], acc[4 * g + 1], acc[4 * g + 2], acc[4 * g + 3]};
        }
        WG_BAR();
        {
            const int col = tidh >> 2, s = tidh & 3;
            float xr[16], zr[16];
#pragma unroll
            for (int m = 0; m < 16; ++m) { zr[m] = 0.f; xr[m] = (col < 64) ? bf2f(PAt[(4 * m + s) * XS + col]) : PX2[(4 * m + s) * NPS + (col - 64)]; }
#pragma unroll
            for (int t = 0; t < 64; ++t) {
                const int nm = (t + 3) >> 2;
                float p0 = (s == (t & 3)) ? xr[t >> 2] : 0.f, p1 = 0.f;
#pragma unroll
                for (int m4 = 0; m4 < (nm + 3) / 4; ++m4) {
                    const f32x4 nv = *(const LAS f32x4*)(PNP + t * NPS + s * 16 + 4 * m4);
                    p0 += nv.x * zr[4 * m4]; if (4 * m4 + 1 < nm) p1 += nv.y * zr[4 * m4 + 1]; if (4 * m4 + 2 < nm) p0 += nv.z * zr[4 * m4 + 2]; if (4 * m4 + 3 < nm) p1 += nv.w * zr[4 * m4 + 3];
                }
                const float tot = quad_sum(p0 + p1);
                zr[t >> 2] = (s == (t & 3)) ? tot : zr[t >> 2];
            }
#pragma unroll
            for (int m = 0; m < 16; ++m) PZT[col * XS + 4 * m + s] = (bf16)f2bf(zr[m]);
        }
        WG_BAR();
        {
            const int tl = wave & 3, mt = tl >> 1, nt = tl & 1;
            f32x16 acc;
#pragma unroll
            for (int e = 0; e < 16; ++e) acc[e] = 0.f;
            if (wave < 4) {
                acc = mm64(PZT + (64 + 32 * mt) * XS, PMB + 32 * nt * XS, r, hh, acc);
                acc = mm64(PVT + 32 * mt * XS, PMK + 32 * nt * XS, r, hh, acc);
                float* hy = (float*)(ws + WS_HYV) + rc * 4096;
#pragma unroll
                for (int g = 0; g < 4; ++g) *(f32x4*)(hy + ((tl * 4 + g) * 64 + (tidh & 63)) * 4) = (f32x4){acc[4 * g], acc[4 * g + 1], acc[4 * g + 2], acc[4 * g + 3]};
#pragma unroll
                for (int e = 0; e < 16; ++e) acc[e] = 0.f;
                acc = mm64(PZT + 32 * mt * XS, PMB + 32 * nt * XS, r, hh, acc);
                bf16* gy = (bf16*)(ws + WS_GY) + rc * 4096; const int t = 32 * nt + r;
#pragma unroll
                for (int g = 0; g < 4; ++g) { const int j0 = 32 * mt + 8 * g + 4 * hh; const v2u rv = *(const LAS v2u*)(PRt + t * XS + j0);
                    v2u w; w.x = pk2(acc[4 * g] + bflo(rv.x), acc[4 * g + 1] + bfhi(rv.x)); w.y = pk2(acc[4 * g + 2] + bflo(rv.y), acc[4 * g + 3] + bfhi(rv.y)); *(v2u*)(gy + t * 64 + j0) = w; }
            } else {
                acc = mm64(PBH + 32 * mt * XS, PZT + (64 + 32 * nt) * XS, r, hh, acc);
                acc = mm64(PKH + 32 * mt * XS, PVT + 32 * nt * XS, r, hh, acc);
#pragma unroll
                for (int g = 0; g < 4; ++g) *(f32x4*)(rec + 8192 + ((tl * 4 + g) * 64 + (tidh & 63)) * 16) = (f32x4){acc[4 * g], acc[4 * g + 1], acc[4 * g + 2], acc[4 * g + 3]};
#pragma unroll
                for (int e = 0; e < 16; ++e) acc[e] = 0.f;
                acc = mm64(PZT + 32 * mt * XS, PBH + 32 * nt * XS, r, hh, acc);
#pragma unroll
                for (int g = 0; g < 4; ++g) { const int f = (nt * 2 + mt) * 2 + (g >> 1);
                    v2u w; w.x = pk2(acc[4 * g], acc[4 * g + 1]); w.y = pk2(acc[4 * g + 2], acc[4 * g + 3]); *(v2u*)(rec + f * 1024 + (tidh & 63) * 16 + (g & 1) * 8) = w; }
            }
        }
        WG_BAR();
    }
}

__device__ __forceinline__ void dma_record(const unsigned char* g, LAS unsigned char* slot, int lane) {
#pragma unroll
    for (int k = 0; k < REC_BYTES / 1024; ++k) __builtin_amdgcn_global_load_lds((const unsigned*)(g + k * 1024 + lane * 16), (LAS unsigned*)(slot + k * 1024), 16, 0, 0);
}
__device__ __forceinline__ void rwkv_scan_unit(unsigned char* ws, LAS unsigned char* lds, int bh, int wave, int lane) {
    const unsigned char* recs = ws + WS_REC + (size_t)bh * 32 * REC_BYTES;
    bf16* st0 = (bf16*)(ws + WS_ST0) + (size_t)bh * 32 * 4096;
    const int r = lane & 31, hh = lane >> 5;
    if (wave >= 1 && wave <= 5) dma_record(recs + (size_t)(wave - 1) * REC_BYTES, lds + (wave - 1) * REC_BYTES, lane);
    f32x16 S[2][2];
#pragma unroll
    for (int a = 0; a < 2; ++a)
#pragma unroll
        for (int b2 = 0; b2 < 2; ++b2)
#pragma unroll
            for (int e = 0; e < 16; ++e) S[a][b2][e] = 0.f;
#pragma nounroll
    for (int c = 0; c < 32; ++c) {
        const int sl = c % 5;
        if (wave == 1 + sl) asm volatile("s_waitcnt vmcnt(0)" ::: "memory");
        asm volatile("s_waitcnt lgkmcnt(0)" ::: "memory"); __builtin_amdgcn_s_barrier(); asm volatile("" ::: "memory");
        if (wave == 0) {
            const LAS unsigned char* slot = lds + sl * REC_BYTES;
            bf16* so = st0 + (size_t)c * 4096;
            bf16x8 Bf[2][2][2];
#pragma unroll
            for (int jt = 0; jt < 2; ++jt)
#pragma unroll
                for (int ct = 0; ct < 2; ++ct) {
#pragma unroll
                    for (int g = 0; g < 4; ++g) { v2u w; w.x = pk2(S[jt][ct][4 * g], S[jt][ct][4 * g + 1]); w.y = pk2(S[jt][ct][4 * g + 2], S[jt][ct][4 * g + 3]);
                        *(v2u*)(so + (32 * ct + r) * 64 + 32 * jt + 8 * g + 4 * hh) = w;
                        Bf[jt][ct][g >> 1][4 * (g & 1) + 0] = (short)(w.x & 0xffff); Bf[jt][ct][g >> 1][4 * (g & 1) + 1] = (short)(w.x >> 16);
                        Bf[jt][ct][g >> 1][4 * (g & 1) + 2] = (short)(w.y & 0xffff); Bf[jt][ct][g >> 1][4 * (g & 1) + 3] = (short)(w.y >> 16); }
                }
            f32x16 Sn[2][2];
#pragma unroll
            for (int jo = 0; jo < 2; ++jo) {
                f32x4 wc[4];
#pragma unroll
                for (int g = 0; g < 4; ++g) wc[g] = *(const LAS f32x4*)(slot + 24576 + (32 * jo + 8 * g + 4 * hh) * 4);
#pragma unroll
                for (int ct = 0; ct < 2; ++ct) {
                    f32x16 acc;
#pragma unroll
                    for (int g = 0; g < 4; ++g) { const f32x4 nv = *(const LAS f32x4*)(slot + 8192 + (((jo * 2 + ct) * 4 + g) * 64 + lane) * 16);
#pragma unroll
                        for (int e = 0; e < 4; ++e) acc[4 * g + e] = nv[e] + wc[g][e] * S[jo][ct][4 * g + e]; }
#pragma unroll
                    for (int jt = 0; jt < 2; ++jt)
#pragma unroll
                        for (int s2 = 0; s2 < 2; ++s2) { const bf16x8 av = *(const LAS bf16x8*)(slot + ((jo * 2 + jt) * 2 + s2) * 1024 + lane * 16);
                            acc = __builtin_amdgcn_mfma_f32_32x32x16_bf16(av, Bf[jt][ct][s2], acc, 0, 0, 0); }
                    Sn[jo][ct] = acc;
                }
            }
#pragma unroll
            for (int a = 0; a < 2; ++a)
#pragma unroll
                for (int b2 = 0; b2 < 2; ++b2) S[a][b2] = Sn[a][b2];
        } else if (c >= 1 && c + 4 < 32 && wave == 1 + ((c + 4) % 5)) {
            dma_record(recs + (size_t)(c + 4) * REC_BYTES, lds + ((c + 4) % 5) * REC_BYTES, lane);
        }
    }
    asm volatile("s_waitcnt vmcnt(0) lgkmcnt(0)" ::: "memory"); __builtin_amdgcn_s_barrier(); asm volatile("" ::: "memory");
}

__device__ __forceinline__ void rwkv_out_unit(const unsigned char* ws, const float* lnw, const float* lnb, bf16* ycat, int unit, int wave, int lane) {
    const int b = unit >> 5, cidx = unit & 31, h = wave >> 1, nt = wave & 1, r = lane & 31, hh = lane >> 5;
    const size_t rc = (size_t)((b * NH + h) * 32 + cidx);
    const bf16* st0 = (const bf16*)(ws + WS_ST0) + rc * 4096; const bf16* gy = (const bf16*)(ws + WS_GY) + rc * 4096; const float* hy = (const float*)(ws + WS_HYV) + rc * 4096;
    const bf16* Vg = (const bf16*)(ws + WS_V); const bf16* Gg = (const bf16*)(ws + WS_G); const float* Bon = (const float*)(ws + WS_BONUS);
    f32x16 acc[2];
#pragma unroll
    for (int mt = 0; mt < 2; ++mt) {
#pragma unroll
        for (int g = 0; g < 4; ++g) { const f32x4 x = *(const f32x4*)(hy + (((mt * 2 + nt) * 4 + g) * 64 + lane) * 4); acc[mt][4 * g] = x.x; acc[mt][4 * g + 1] = x.y; acc[mt][4 * g + 2] = x.z; acc[mt][4 * g + 3] = x.w; }
#pragma unroll
        for (int ks = 0; ks < 4; ++ks) { const bf16x8 av = *(const bf16x8*)(st0 + (32 * mt + r) * 64 + 16 * ks + 8 * hh), bv = *(const bf16x8*)(gy + (32 * nt + r) * 64 + 16 * ks + 8 * hh);
            acc[mt] = __builtin_amdgcn_mfma_f32_32x32x16_bf16(av, bv, acc[mt], 0, 0, 0); }
    }
    float s1 = 0.f;
#pragma unroll
    for (int mt = 0; mt < 2; ++mt)
#pragma unroll
        for (int e = 0; e < 16; ++e) s1 += acc[mt][e];
    s1 += __shfl_xor(s1, 32);
    const float mean = s1 * (1.f / 64.f); float s2 = 0.f;
#pragma unroll
    for (int mt = 0; mt < 2; ++mt)
#pragma unroll
        for (int e = 0; e < 16; ++e) { const float d = acc[mt][e] - mean; s2 += d * d; }
    s2 += __shfl_xor(s2, 32);
    const float rstd = __builtin_amdgcn_rsqf(s2 * (1.f / 64.f) + GN_EPS);
    const size_t tok = (size_t)(b * SEQ + cidx * 64 + 32 * nt + r);
    const float bon = Bon[tok * NH + h];
#pragma unroll
    for (int mt = 0; mt < 2; ++mt)
#pragma unroll
        for (int g = 0; g < 4; ++g) {
            const int i0 = 64 * h + 32 * mt + 8 * g + 4 * hh;
            const f32x4 gw = *(const f32x4*)(lnw + i0), gb = *(const f32x4*)(lnb + i0);
            const v2u vv = *(const v2u*)(Vg + tok * GW + i0), gg = *(const v2u*)(Gg + tok * GW + i0);
            const float o0 = ((acc[mt][4 * g] - mean) * rstd * gw.x + gb.x + bon * bflo(vv.x)) * bflo(gg.x);
            const float o1 = ((acc[mt][4 * g + 1] - mean) * rstd * gw.y + gb.y + bon * bfhi(vv.x)) * bfhi(gg.x);
            const float o2 = ((acc[mt][4 * g + 2] - mean) * rstd * gw.z + gb.z + bon * bflo(vv.y)) * bflo(gg.y);
            const float o3 = ((acc[mt][4 * g + 3] - mean) * rstd * gw.w + gb.w + bon * bfhi(vv.y)) * bfhi(gg.y);
            v2u w; w.x = pk2(o0, o1); w.y = pk2(o2, o3);
            *(v2u*)(ycat + tok * DM + 512 + i0) = w;
        }
}

constexpr int PH_PER_LAYER = 12, N_PHASES = 1 + DEPTH * PH_PER_LAYER;
__global__ void __launch_bounds__(NWAVES * 64, 2) mega_fwd(Args args) {
    extern __shared__ __attribute__((aligned(16))) unsigned char lds_raw[];
    LAS unsigned char* lds = (LAS unsigned char*)lds_raw;
    const int G = gridDim.x, bx = blockIdx.x;
    const int vcu = (G % 8 == 0) ? (bx % 8) * (G / 8) + bx / 8 : bx;
    const int NGW = G * NWAVES;
    unsigned char* ws = args.ws;
    volatile LAS unsigned* MISC = (volatile LAS unsigned*)(lds + MISC_OFF);
    for (int u = threadIdx.x; u < (LDS_BYTES - LDSCTL_OFF) / 4; u += NWAVES * 64) ((LAS unsigned*)(lds + LDSCTL_OFF))[u] = 0u;
    __syncthreads();
    XcdBarrier bar; bar.bar = (unsigned*)(ws + WS_CTL) + CW_BAR; bar.x = 0; bar.st = nullptr;
    if (MK_ONE_LAUNCH) bar = xcd_barrier_post((unsigned*)(ws + WS_CTL) + CW_BAR, MISC + 8);
    const int lo = args.ph_lo, hi = args.ph_hi;
#define IN(k) (lo <= (k) && (k) < hi)
#define SEAM(k) do { if (MK_ONE_LAUNCH && IN(k) && IN((k) + 1)) xcd_barrier(bar); } while (0)

    float* X = args.out;
    bf16* HB = (bf16*)(ws + WS_HB); bf16* PH = (bf16*)(ws + WS_PH); bf16* Y = (bf16*)(ws + WS_Y); bf16* YCAT = HB;

#pragma nounroll
    for (int p = lo; p < hi; ++p) {
        const int l = (p == 0) ? 0 : (p - 1) / PH_PER_LAYER, k = (p == 0) ? -1 : (p - 1) % PH_PER_LAYER;
        int tid = threadIdx.x; asm volatile("" : "+v"(tid));
        const int lane = tid & 63, wave = __builtin_amdgcn_readfirstlane(tid >> 6), gw = vcu * NWAVES + wave;
        if (k == 0 || k == 9) {
            pg8::Gemm g{HB, (const bf16*)(ws + (k == 0 ? WS_WGU1 : WS_WGU2)), M, 2 * DFF, DM}; pg8::StaticOrder S; S.init(M, 2 * DFF, G, bx); pg8::EpiSwiGLU E{PH, DFF};
            if (!DBG_NO_GEMM) pg8::gemm_phase<pg8::EpiSwiGLU, pg8::StaticOrder, true, true>(lds, g, S, E, tid);
        } else if (k == 1 || k == 3 || k == 7 || k == 10) {
            const bf16* A = (k == 3) ? HB : (k == 7 ? YCAT : PH);
            const size_t wo = (k == 1) ? WS_WD1 : (k == 3) ? WS_WIN : (k == 7) ? WS_WOUT : WS_WD2;
            const int N = (k == 3) ? INP : DM, K = (k == 1 || k == 10) ? DFF : DM;
            pg8::Gemm g{A, (const bf16*)(ws + wo), M, N, K}; pg8::StaticOrder S; S.init(M, N, G, bx); pg8::EpiBf16 E{(k == 3) ? PH : Y, N};
            if (!DBG_NO_GEMM) pg8::gemm_phase<pg8::EpiBf16, pg8::StaticOrder, true, true>(lds, g, S, E, tid);
        } else if (k == -1) {
            convert_weights(args, 0, lds, gw, NGW, wave, lane);
            row_phase(args.in[I_X], X, nullptr, nullptr, 0.f, args.in[I_F1PRE], HB, gw, NGW, lane);
        } else if (k == 2 || k == 8 || k == 11) {
            if (k == 11 && l + 1 < DEPTH) convert_weights(args, l + 1, lds, gw, NGW, wave, lane);
            const float* gpost = (k == 2 ? args.in[I_F1POST] : k == 8 ? args.in[I_MIXPOST] : args.in[I_F2POST]) + l * DM;
            const float* gnext = (k == 2) ? args.in[I_MIXPRE] + l * DM : (k == 8) ? args.in[I_F2PRE] + l * DM : ((l + 1 < DEPTH) ? args.in[I_F1PRE] + (l + 1) * DM : nullptr);
            row_phase(X, X, Y, gpost, k == 8 ? 1.0f : 0.5f, gnext, HB, gw, NGW, lane);
        } else if (k == 4) {
            for (int u = vcu; u < 256 + 256 + 128 + 256; u += G) {
                int ll = l; asm volatile("" : "+s"(ll)); int tid = threadIdx.x; asm volatile("" : "+v"(tid)); const int lane = tid & 63, wave = __builtin_amdgcn_readfirstlane(tid >> 6);
                if (u < 256) {
                    RwkvW RW{args.in[I_MU] + ll * 896, args.in[I_W0] + ll * GW, args.in[I_WUP] + ll * 32 * GW, args.in[I_A0] + ll * GW, args.in[I_AUP] + ll * 32 * GW, args.in[I_GUP] + ll * 64 * GW,
                             args.in[I_KK] + ll * GW, args.in[I_KA] + ll * GW, args.in[I_RK] + ll * GW};
                    if (!DBG_NO_PREP) rwkv_chunk_unit(PH, RW, ws, lds, u, tid, wave, lane); }
                else if (u < 512) { if (!DBG_NO_D) mixD_unit(PH, args.in[I_CMW] + ll * 31 * GW, args.in[I_CMB] + ll * GW, args.in[I_CMLNW] + ll * GW, args.in[I_CMLNB] + ll * GW, YCAT, lds, u - 256, tid, wave, lane); }
                else if (u < 640) { if (!DBG_NO_B) mixB_unit(PH, args.in[I_SGLNW] + ll * GW, args.in[I_SGLNB] + ll * GW, args.in[I_SGW] + (size_t)ll * NH * 128 * 128, args.in[I_SGB] + ll * NH * 128, YCAT, lds, u - 512, tid, wave, lane); }
                else mixA_unit(PH, args.in[I_SCW] + ll * 3 * GW, YCAT, u - 640, tid);
            }
        } else if (k == 5) {
            for (int u = vcu; u < BATCH * NH; u += G) { if (!DBG_NO_SCAN) rwkv_scan_unit(ws, lds, u, wave, lane); }
        } else {
            for (int u = vcu; u < M / 64; u += G) rwkv_out_unit(ws, args.in[I_RLNW] + l * GW, args.in[I_RLNB] + l * GW, YCAT, u, wave, lane);
        }
        if (MK_ONE_LAUNCH && p + 1 < hi) xcd_barrier(bar);
    }
#undef IN
#undef SEAM
}

extern "C" void kernel_launch(void* const* d_in, const int* in_sizes, int n_in, void* d_out, int out_size, void* d_ws, size_t ws_size, hipStream_t stream) {
    static int grid = 0;
    if (grid == 0) {
        if (n_in != N_IN || in_sizes[0] != M * DM || out_size != M * DM || ws_size < WS_END) { fprintf(stderr, "kernel_launch: unexpected shapes (n_in %d, in0 %d, out %d, ws %zu)\n", n_in, n_in > 0 ? in_sizes[0] : -1, out_size, ws_size); grid = -1; return; }
        int dev = 0, cus = 0, per_cu = 0;
        if (hipGetDevice(&dev) != hipSuccess || hipDeviceGetAttribute(&cus, hipDeviceAttributeMultiprocessorCount, dev) != hipSuccess) { grid = -1; return; }
        if (hipFuncSetAttribute((const void*)mega_fwd, hipFuncAttributeMaxDynamicSharedMemorySize, LDS_BYTES) != hipSuccess) { fprintf(stderr, "kernel_launch: hipFuncSetAttribute failed\n"); grid = -1; return; }
        if (hipOccupancyMaxActiveBlocksPerMultiprocessor(&per_cu, (const void*)mega_fwd, NWAVES * 64, LDS_BYTES) != hipSuccess || per_cu < 1) { fprintf(stderr, "kernel_launch: occupancy query says %d blocks per CU\n", per_cu); (void)hipGetLastError(); grid = -1; return; }
        grid = cus;
    }
    if (grid < 0) return;
    (void)hipMemsetAsync((char*)d_ws + WS_CTL, 0, CTL_ZERO_BYTES, stream);
    Args a{};
    for (int i = 0; i < N_IN; ++i) a.in[i] = (const float*)d_in[i];
    a.out = (float*)d_out; a.ws = (unsigned char*)d_ws;
#if MK_ONE_LAUNCH
    a.ph_lo = 0; a.ph_hi = N_PHASES;
    void* kargs[] = {&a};
    hipError_t e = hipLaunchCooperativeKernel((const void*)mega_fwd, dim3(grid), dim3(NWAVES * 64), kargs, LDS_BYTES, stream);
    if (e != hipSuccess) fprintf(stderr, "kernel_launch: cooperative launch failed: %s (grid %d)\n", hipGetErrorString(e), grid);
#else
    for (int p = 0; p < N_PHASES; ++p) { a.ph_lo = p; a.ph_hi = p + 1; hipLaunchKernelGGL(mega_fwd, dim3(grid), dim3(NWAVES * 64), LDS_BYTES, stream, a); }
#endif
}
```

```cpp
#include <hip/hip_runtime.h>
#include <cstdio>
#include <cstdint>

#ifndef DBG_NO_PREP
#define DBG_NO_PREP 0
#endif
#ifndef DBG_NO_D
#define DBG_NO_D 0
#endif
#ifndef DBG_NO_B
#define DBG_NO_B 0
#endif
#ifndef DBG_NO_SCAN
#define DBG_NO_SCAN 0
#endif
#ifndef DBG_NO_GEMM
#define DBG_NO_GEMM 0
#endif
#ifndef REP_GEMM
#define REP_GEMM 1
#endif
#ifndef REP_MIX
#define REP_MIX 1
#endif
#ifndef REP_CH
#define REP_CH 1
#endif
#ifndef REP_D
#define REP_D 1
#endif
#ifndef REP_B
#define REP_B 1
#endif
#ifndef REP_A
#define REP_A 1
#endif
#ifndef REP_X2
#define REP_X2 1
#endif
#ifndef REP_X3
#define REP_X3 1
#endif
#ifndef REP_CONV
#define REP_CONV 1
#endif
#ifndef MK_ONE_LAUNCH
#define MK_ONE_LAUNCH 1
#endif

namespace pg8 {
#define PG8_LAS __attribute__((address_space(3)))
typedef unsigned short bf16_t;
typedef short bf16x8 __attribute__((ext_vector_type(8)));
typedef float f32x4 __attribute__((ext_vector_type(4)));
typedef unsigned u32x4 __attribute__((ext_vector_type(4)));
constexpr int BM = 256, BK = 64, HALF = 128, HTB = HALF * BK * 2, STAGE_BYTES = 8 * HTB, NXCD = 8, WGM = 8;

__host__ __device__ __forceinline__ int lds_byte(int r, int c) { const int st = (r >> 4) * 2 + (c >> 5), rr = r & 15, cc = c & 31, ob = rr * 64 + cc * 2; return st * 1024 + (ob ^ (((ob >> 9) & 1) << 5)); }
__host__ __device__ __forceinline__ void stage_rc(int b, int& R, int& C) { const int st = b / 1024, sb = b % 1024, swz = sb ^ (((sb >> 9) & 1) << 5); R = (st >> 1) * 16 + swz / 64; C = (st & 1) * 32 + (swz % 64) / 2; }
__host__ __device__ __forceinline__ int perm32(int rho) { const int n = rho >> 4, i = rho & 15; return 8 * (i >> 2) + 4 * n + (i & 3); }

struct Unit { int pm, pn; };
struct Gemm { const bf16_t* A; const bf16_t* Bt; int M, N, K; };

struct StaticOrder {
    int nM, nN, nwg, G, c;
    __host__ __device__ void init(int M, int N, int G_, int c_) { nM = M / BM; nN = N / BM; nwg = nM * nN; G = G_; c = c_; }
    __host__ __device__ bool next(int i, Unit& u) const {
        const int L = i * G + c; if (L >= nwg) return false;
        int wgid = L; { const int q = nwg / NXCD, r = nwg % NXCD, xcd = wgid % NXCD, off = wgid / NXCD; wgid = (xcd < r ? xcd * (q + 1) : r * (q + 1) + (xcd - r) * q) + off; }
        const int nig = WGM * nN, gid = wgid / nig, fm = gid * WGM, gsz = (nM - fm) < WGM ? (nM - fm) : WGM;
        u.pm = fm + ((wgid % nig) % gsz); u.pn = (wgid % nig) / gsz; return true;
    }
    __device__ __forceinline__ void a_ready(const Unit&) const {}
    __device__ __forceinline__ void done(const Unit&) const {}
};

typedef __bf16 bf16x2_t __attribute__((ext_vector_type(2))); typedef float f32x2_t __attribute__((ext_vector_type(2)));
__device__ __forceinline__ unsigned cvt_pk_bf16(float lo, float hi) { return __builtin_bit_cast(unsigned, __builtin_convertvector((f32x2_t){lo, hi}, bf16x2_t)); }

struct EpiBf16 {
    static constexpr bool PERM = true, AFTER_DRAIN = false;
    bf16_t* O; int ldc;
    __device__ __forceinline__ void operator()(const f32x4 (&acc)[2][2][4][2], const Unit& u, int wr, int wc, int fr, int fq) const {
        const int row0 = u.pm * BM + wr * 64 + fr; const int col0 = u.pn * BM + wc * 32 + 8 * fq;
#pragma unroll
        for (int ai = 0; ai < 2; ++ai)
#pragma unroll
            for (int m = 0; m < 4; ++m) { bf16_t* rowp = O + (size_t)(row0 + ai * HALF + m * 16) * ldc + col0;
#pragma unroll
                for (int bj = 0; bj < 2; ++bj) { const f32x4 v0 = acc[ai][bj][m][0], v1 = acc[ai][bj][m][1];
                    u32x4 w; w.x = cvt_pk_bf16(v0[0], v0[1]); w.y = cvt_pk_bf16(v0[2], v0[3]); w.z = cvt_pk_bf16(v1[0], v1[1]); w.w = cvt_pk_bf16(v1[2], v1[3]);
                    *(u32x4*)(rowp + bj * HALF) = w; } }
    }
};
__device__ __forceinline__ float silu_f(float x) { return x * __builtin_amdgcn_rcpf(1.0f + __expf(-x)); }
struct EpiSwiGLU {
    static constexpr bool PERM = true, AFTER_DRAIN = false;
    bf16_t* O; int ldc;
    __device__ __forceinline__ void operator()(const f32x4 (&acc)[2][2][4][2], const Unit& u, int wr, int wc, int fr, int fq) const {
        const int row0 = u.pm * BM + wr * 64 + fr; const int col0 = u.pn * HALF + wc * 32 + 8 * fq;
#pragma unroll
        for (int ai = 0; ai < 2; ++ai)
#pragma unroll
            for (int m = 0; m < 4; ++m) { bf16_t* rowp = O + (size_t)(row0 + ai * HALF + m * 16) * ldc + col0;
                const f32x4 g0 = acc[ai][0][m][0], g1 = acc[ai][0][m][1], u0 = acc[ai][1][m][0], u1 = acc[ai][1][m][1];
                float h[8];
#pragma unroll
                for (int e = 0; e < 4; ++e) { h[e] = silu_f(g0[e]) * u0[e]; h[4 + e] = silu_f(g1[e]) * u1[e]; }
                u32x4 w; w.x = cvt_pk_bf16(h[0], h[1]); w.y = cvt_pk_bf16(h[2], h[3]); w.z = cvt_pk_bf16(h[4], h[5]); w.w = cvt_pk_bf16(h[6], h[7]);
                *(u32x4*)rowp = w; }
    }
};

template <class Epi, class Sched, bool ALIGN_EPI = false, bool SP2 = false>
__device__ __forceinline__ void gemm_phase(PG8_LAS unsigned char* lds, const Gemm g, const Sched& S, const Epi& E, const int tid) {
    const int wid = __builtin_amdgcn_readfirstlane(tid >> 6), lane = tid & 63, wr = wid >> 2, wc = wid & 3, fr = lane & 15, fq = lane >> 4;
    const int K = g.K, nt = K / BK;
    unsigned voffA[2], voffB[2];
#pragma unroll
    for (int i = 0; i < 2; ++i) { int R, C; stage_rc(tid * 16 + i * 8192, R, C); const int Rb = Epi::PERM ? ((R & ~31) + perm32(R & 31)) : R;
        voffA[i] = (unsigned)(R * K + C) * 2u; voffB[i] = (unsigned)(Rb * K + C) * 2u; }
    const size_t kstep = (size_t)(BK * 2);
    const size_t hstep = (size_t)HALF * K * 2;
    const size_t tstep = 2 * hstep;
    const unsigned ldsw = (unsigned)wid * 1024u;
    const int aoff = lds_byte(wr * 64 + fr, fq * 8), boff = lds_byte(wc * 32 + fr, fq * 8);
#define PG8_SA(b, h) (((b) * 2 + (h)) * HTB)
#define PG8_SB(b, h) ((4 + (b) * 2 + (h)) * HTB)
#define PG8_STAGE(bufoff, gbase, voff) do { _Pragma("unroll") for (int _i = 0; _i < 2; ++_i) \
        __builtin_amdgcn_global_load_lds((const unsigned*)((const char*)(gbase) + (voff)[_i]), (PG8_LAS unsigned*)(lds + (bufoff) + ldsw + _i * 8192), 16, 0, 0); } while (0)
#define PG8_LDA(dst, b, h) do { _Pragma("unroll") for (int m = 0; m < 4; ++m) _Pragma("unroll") for (int k = 0; k < 2; ++k) dst[m][k] = *(const PG8_LAS bf16x8*)(lds + PG8_SA(b, h) + aoff + m * 2048 + k * 1024); } while (0)
#define PG8_LDB(dst, b, h) do { _Pragma("unroll") for (int n = 0; n < 2; ++n) _Pragma("unroll") for (int k = 0; k < 2; ++k) dst[n][k] = *(const PG8_LAS bf16x8*)(lds + PG8_SB(b, h) + boff + n * 2048 + k * 1024); } while (0)
#define PG8_MMA(ai, bj, At, Bt) do { __builtin_amdgcn_s_setprio(1); _Pragma("unroll") for (int m = 0; m < 4; ++m) _Pragma("unroll") for (int n = 0; n < 2; ++n) _Pragma("unroll") for (int k = 0; k < 2; ++k) \
        acc[ai][bj][m][n] = __builtin_amdgcn_mfma_f32_16x16x32_bf16(Bt[n][k], At[m][k], acc[ai][bj][m][n], 0, 0, 0); __builtin_amdgcn_s_setprio(0); } while (0)
#define PG8_WAIT_V(n) asm volatile("s_waitcnt vmcnt(" #n ")" ::: "memory")
#define PG8_WAIT_L(n) asm volatile("s_waitcnt lgkmcnt(" #n ")" ::: "memory")
#define PG8_BAR __builtin_amdgcn_s_barrier()
#define PG8_SCHED __builtin_amdgcn_sched_barrier(0)
    Unit cur, nxt; int ui = 0;
    if (!S.next(0, cur)) return;
    f32x4 acc[2][2][4][2];
#pragma unroll
    for (int a = 0; a < 2; ++a)
#pragma unroll
        for (int b = 0; b < 2; ++b)
#pragma unroll
            for (int m = 0; m < 4; ++m)
#pragma unroll
                for (int n = 0; n < 2; ++n) acc[a][b][m][n] = (f32x4){0.f, 0.f, 0.f, 0.f};
    bf16x8 At[4][2], B0[2][2], B1[2][2];
    const char* cA = (const char*)g.A + (size_t)cur.pm * tstep; const char* cB = (const char*)g.Bt + (size_t)cur.pn * tstep;
    S.a_ready(cur);
    if constexpr (SP2) {
        PG8_STAGE(PG8_SB(0, 0), cB, voffB); PG8_STAGE(PG8_SB(0, 1), cB + hstep, voffB); PG8_STAGE(PG8_SA(0, 0), cA, voffA); PG8_STAGE(PG8_SA(0, 1), cA + hstep, voffA);
        if (wr == 1) PG8_BAR;
        PG8_WAIT_V(2); PG8_BAR;
        PG8_STAGE(PG8_SB(1, 0), cB + kstep, voffB); PG8_STAGE(PG8_SA(1, 0), cA + kstep, voffA); PG8_STAGE(PG8_SB(1, 1), cB + hstep + kstep, voffB);
        PG8_WAIT_V(6); PG8_BAR;
    } else {
        PG8_STAGE(PG8_SB(0, 0), cB, voffB); PG8_STAGE(PG8_SA(0, 0), cA, voffA); PG8_STAGE(PG8_SB(0, 1), cB + hstep, voffB); PG8_STAGE(PG8_SA(0, 1), cA + hstep, voffA);
        if (wr == 1) PG8_BAR;
        PG8_WAIT_V(4); PG8_BAR;
        PG8_STAGE(PG8_SB(1, 0), cB + kstep, voffB); PG8_STAGE(PG8_SA(1, 0), cA + kstep, voffA); PG8_STAGE(PG8_SB(1, 1), cB + hstep + kstep, voffB);
        PG8_WAIT_V(6); PG8_BAR;
    }
    for (;;) {
        const bool has_next = S.next(ui + 1, nxt);
        const char* nA = has_next ? (const char*)g.A + (size_t)nxt.pm * tstep : cA; const char* nB = has_next ? (const char*)g.Bt + (size_t)nxt.pn * tstep : cB;
        for (int t = 0; t < nt; t += 2) {
            const bool last = (t == nt - 2);
            const char* a1 = cA + (size_t)(t + 1) * kstep;
            const char* a2 = last ? nA : cA + (size_t)(t + 2) * kstep; const char* b2 = last ? nB : cB + (size_t)(t + 2) * kstep;
            const char* a3 = a2 + kstep; const char* b3 = b2 + kstep;
            if (last && has_next) S.a_ready(nxt);
            if constexpr (SP2) {
            PG8_LDB(B0, 0, 0); PG8_LDB(B1, 0, 1); PG8_SCHED; PG8_LDA(At, 0, 0); PG8_STAGE(PG8_SA(1, 1), a1 + hstep, voffA);
            PG8_WAIT_V(8); PG8_WAIT_L(0); PG8_BAR; PG8_MMA(0, 0, At, B0); PG8_MMA(0, 1, At, B1); PG8_BAR; PG8_SCHED;
            PG8_LDA(At, 0, 1); PG8_STAGE(PG8_SB(0, 0), b2, voffB); PG8_STAGE(PG8_SB(0, 1), b2 + hstep, voffB); PG8_STAGE(PG8_SA(0, 0), a2, voffA);
            PG8_WAIT_V(8); PG8_WAIT_L(0); PG8_BAR; PG8_MMA(1, 0, At, B0); PG8_MMA(1, 1, At, B1); PG8_BAR; PG8_SCHED;
            PG8_LDB(B0, 1, 0); PG8_LDB(B1, 1, 1); PG8_SCHED; PG8_LDA(At, 1, 0); PG8_STAGE(PG8_SA(0, 1), a2 + hstep, voffA);
            PG8_WAIT_V(8); PG8_WAIT_L(0); PG8_BAR; PG8_MMA(0, 0, At, B0); PG8_MMA(0, 1, At, B1); PG8_BAR; PG8_SCHED;
            PG8_LDA(At, 1, 1); PG8_STAGE(PG8_SB(1, 0), b3, voffB); PG8_STAGE(PG8_SB(1, 1), b3 + hstep, voffB); PG8_STAGE(PG8_SA(1, 0), a3, voffA);
            PG8_WAIT_V(8); PG8_WAIT_L(0); PG8_BAR; PG8_MMA(1, 0, At, B0); PG8_MMA(1, 1, At, B1); PG8_BAR; PG8_SCHED;
            } else {
            PG8_LDB(B0, 0, 0); PG8_SCHED; PG8_LDA(At, 0, 0); PG8_STAGE(PG8_SA(1, 1), a1 + hstep, voffA);
            PG8_WAIT_L(8); PG8_BAR; PG8_WAIT_L(0); PG8_MMA(0, 0, At, B0); PG8_BAR; PG8_SCHED;
            PG8_LDB(B1, 0, 1); PG8_STAGE(PG8_SB(0, 0), b2, voffB);
            PG8_BAR; PG8_WAIT_L(0); PG8_MMA(0, 1, At, B1); PG8_BAR;
            PG8_LDA(At, 0, 1); PG8_STAGE(PG8_SA(0, 0), a2, voffA);
            PG8_BAR; PG8_WAIT_L(0); PG8_MMA(1, 0, At, B0); PG8_BAR; PG8_SCHED;
            PG8_STAGE(PG8_SB(0, 1), b2 + hstep, voffB);
            PG8_WAIT_V(6); PG8_BAR; PG8_MMA(1, 1, At, B1); PG8_BAR;
            PG8_LDB(B0, 1, 0); PG8_SCHED; PG8_LDA(At, 1, 0); PG8_STAGE(PG8_SA(0, 1), a2 + hstep, voffA);
            PG8_WAIT_L(8); PG8_BAR; PG8_WAIT_L(0); PG8_MMA(0, 0, At, B0); PG8_BAR; PG8_SCHED;
            PG8_LDB(B1, 1, 1); PG8_STAGE(PG8_SB(1, 0), b3, voffB);
            PG8_BAR; PG8_WAIT_L(0); PG8_MMA(0, 1, At, B1); PG8_BAR;
            PG8_LDA(At, 1, 1); PG8_STAGE(PG8_SA(1, 0), a3, voffA);
            PG8_BAR; PG8_WAIT_L(0); PG8_MMA(1, 0, At, B0); PG8_BAR; PG8_SCHED;
            PG8_STAGE(PG8_SB(1, 1), b3 + hstep, voffB);
            PG8_WAIT_V(6); PG8_BAR; PG8_MMA(1, 1, At, B1); PG8_BAR;
            }
        }
        if constexpr (ALIGN_EPI) { if (wr == 0) PG8_BAR; }
        if constexpr (!Epi::AFTER_DRAIN) { E(acc, cur, wr, wc, fr, fq); S.done(cur); }
        if (!has_next) break;
#pragma unroll
        for (int a = 0; a < 2; ++a)
#pragma unroll
            for (int b = 0; b < 2; ++b)
#pragma unroll
                for (int m = 0; m < 4; ++m)
#pragma unroll
                    for (int n = 0; n < 2; ++n) acc[a][b][m][n] = (f32x4){0.f, 0.f, 0.f, 0.f};
        cur = nxt; cA = nA; cB = nB; ++ui;
        if constexpr (ALIGN_EPI) { if (wr == 1) PG8_BAR; }
    }
    PG8_WAIT_V(0);
    if constexpr (!ALIGN_EPI) { if (wr == 0) PG8_BAR; }
    PG8_BAR;
#undef PG8_SA
#undef PG8_SB
#undef PG8_STAGE
#undef PG8_LDA
#undef PG8_LDB
#undef PG8_MMA
#undef PG8_WAIT_V
#undef PG8_WAIT_L
#undef PG8_BAR
#undef PG8_SCHED
}
}

constexpr int NWAVES = 8;
constexpr int BATCH = 8, SEQ = 2048, DM = 1024, M = BATCH * SEQ, DFF = 2816, DEPTH = 2;
constexpr int GW = 256, NH = 4, HD = 64;
constexpr int INC = 2688, INP = 2816;
constexpr int CA = 0, CB = 768, CC = 1280, CD = 2176;
constexpr float RMS_EPS = 1e-6f, LN_EPS = 1e-5f, GN_EPS = 1e-5f * 64.f;

enum { I_X = 0, I_F1PRE, I_F1G, I_F1U, I_F1D, I_F1POST, I_MIXPRE, I_WIN, I_SCW, I_SGLNW, I_SGLNB, I_SGW, I_SGB, I_MU, I_W0, I_WUP, I_A0, I_AUP, I_GUP, I_KK, I_KA, I_RK,
       I_RLNW, I_RLNB, I_CMW, I_CMB, I_CMLNW, I_CMLNB, I_WOUT, I_MIXPOST, I_F2PRE, I_F2G, I_F2U, I_F2D, I_F2POST, N_IN };

constexpr size_t MiB = 1u << 20;
constexpr size_t WS_CTL = 0, CTL_ZERO_BYTES = 1 * MiB;
constexpr size_t WS_WGU1 = 1 * MiB;
constexpr size_t WS_WD1 = 12 * MiB;
constexpr size_t WS_WIN = WS_WD1 + 5 * MiB + MiB / 2;
constexpr size_t WS_WOUT = 23 * MiB;
constexpr size_t WS_WGU2 = 25 * MiB;
constexpr size_t WS_WD2 = 36 * MiB;
constexpr size_t WS_PH = 42 * MiB;
constexpr size_t WS_HB = 130 * MiB;
constexpr size_t WS_Y = 162 * MiB;
constexpr size_t WS_G = WS_Y, WS_V = WS_Y + 8 * MiB, WS_BONUS = WS_Y + 16 * MiB;
constexpr size_t WS_REC = 194 * MiB;
constexpr size_t WS_GY = 219 * MiB;
constexpr size_t WS_HYV = 227 * MiB;
constexpr size_t WS_ST0 = 243 * MiB;
constexpr size_t WS_END = 251 * MiB;
constexpr int CW_BAR = 4096;

constexpr int RING_BYTES = 131072;
constexpr int LDSCTL_OFF = 145408, MISC_OFF = LDSCTL_OFF + 320;
constexpr int LDS_BYTES = 147456;

#define GAS __attribute__((address_space(1)))
#define LAS __attribute__((address_space(3)))
typedef unsigned short bf16;
typedef unsigned v4u __attribute__((ext_vector_type(4)));
typedef unsigned v2u __attribute__((ext_vector_type(2)));
typedef float f32x4 __attribute__((ext_vector_type(4)));
typedef float f32x16 __attribute__((ext_vector_type(16)));
typedef short bf16x8 __attribute__((ext_vector_type(8)));
typedef GAS unsigned gu32;
#define LDS_WAIT() asm volatile("s_waitcnt lgkmcnt(0)" ::: "memory")
#define VM_WAIT() asm volatile("s_waitcnt vmcnt(0)" ::: "memory")
__device__ __forceinline__ unsigned f2bf(float f) { unsigned u = __builtin_bit_cast(unsigned, f); return (u + 0x7fffu + ((u >> 16) & 1u)) >> 16; }
__device__ __forceinline__ unsigned pk2(float lo, float hi) { return pg8::cvt_pk_bf16(lo, hi); }
__device__ __forceinline__ float bf2f(unsigned h) { return __builtin_bit_cast(float, h << 16); }
__device__ __forceinline__ float sx(short v) { return __builtin_bit_cast(float, (unsigned)(unsigned short)v << 16); }
__device__ __forceinline__ float bflo(unsigned w) { return __builtin_bit_cast(float, w << 16); }
__device__ __forceinline__ float bfhi(unsigned w) { return __builtin_bit_cast(float, w & 0xffff0000u); }
__device__ __forceinline__ float fexp(float x) { return __builtin_amdgcn_exp2f(x * 1.4426950408889634f); }
__device__ __forceinline__ float sigmoid_f(float x) { return __builtin_amdgcn_rcpf(1.0f + fexp(-x)); }

#define XB_TMO      128
#define XB_XCNT(j)  (256  + 64 * (j))
#define XB_XSUB(j)  (1280 + 64 * (j))
#define XB_XGEN(j)  (2304 + 64 * (j))
#define XB_TOP      3328
#define XB_TOPGEN   3392
#define XCD_BAR_WORDS 3456
#define XB_SPIN_CAP (1u << 20)
__device__ __forceinline__ unsigned xb_ld(unsigned* p)              { return __hip_atomic_load(p, __ATOMIC_RELAXED, __HIP_MEMORY_SCOPE_AGENT); }
__device__ __forceinline__ unsigned xb_add(unsigned* p, unsigned v) { return __hip_atomic_fetch_add(p, v, __ATOMIC_RELAXED, __HIP_MEMORY_SCOPE_AGENT); }
__device__ __forceinline__ unsigned xb_xcc_id() { return (unsigned)__builtin_amdgcn_s_getreg((3 << 11) | 20) & 0xFu; }
#define XB_SPIN(cond, bar) do { unsigned _sp = 0; while (cond) { __builtin_amdgcn_s_sleep(1); \
    if ((++_sp & 255u) == 0u) { if (xb_ld(&(bar)[XB_TMO])) break; if (_sp > XB_SPIN_CAP) { atomicAdd(&(bar)[XB_TMO], 1u); break; } } } } while (0)
struct XcdBarrier { unsigned* bar; unsigned x; volatile LAS unsigned* st; };
__device__ __forceinline__ XcdBarrier xcd_barrier_post(unsigned* bar, volatile LAS unsigned* st) {
    XcdBarrier b; b.bar = bar; b.x = xb_xcc_id(); b.st = st;
    if (threadIdx.x == 0) (void)xb_add(&bar[XB_XCNT(b.x)], 1u);
    return b;
}
__device__ __forceinline__ void xcd_barrier_complete(unsigned* bar, unsigned x, unsigned& nloc, unsigned& nx) {
    const unsigned G = gridDim.x * gridDim.y * gridDim.z;
    unsigned sum, cnt, mine, sp = 0u;
    for (;;) {
        sum = 0u; cnt = 0u; mine = 0u;
#pragma unroll
        for (unsigned j = 0; j < 16; ++j) { const unsigned c = xb_ld(&bar[XB_XCNT(j)]); sum += c; cnt += (c > 0u) ? 1u : 0u; mine = (j == x) ? c : mine; }
        if (sum == G) break;
        __builtin_amdgcn_s_sleep(1);
        if ((++sp & 255u) == 0u) { if (xb_ld(&bar[XB_TMO])) break; if (sp > XB_SPIN_CAP) { atomicAdd(&bar[XB_TMO], 1u); break; } }
    }
    nloc = mine > 0u ? mine : 1u; nx = cnt > 0u ? cnt : 1u;
}
__device__ __forceinline__ void xcd_barrier(const XcdBarrier& b) {
    asm volatile("s_waitcnt vmcnt(0)" ::: "memory");
    __syncthreads();
    if (threadIdx.x == 0) {
        unsigned* bar = b.bar;
        __builtin_amdgcn_s_waitcnt(0);
        unsigned nloc = b.st[0], nx = b.st[1];
        if (nloc == 0u) { xcd_barrier_complete(bar, b.x, nloc, nx); b.st[0] = nloc; b.st[1] = nx; }
        const unsigned old = xb_add(&bar[XB_XSUB(b.x)], 1u);
        const unsigned gen = old / nloc;
        if (old + 1u == (gen + 1u) * nloc) {
            __builtin_amdgcn_fence(__ATOMIC_RELEASE, "agent");
            asm volatile("s_waitcnt vmcnt(0)" ::: "memory");
            const unsigned og = xb_add(&bar[XB_TOP], 1u);
            const unsigned tg = og / nx;
            if (og + 1u == (tg + 1u) * nx) xb_add(&bar[XB_TOPGEN], 1u);
            else XB_SPIN(xb_ld(&bar[XB_TOPGEN]) == tg, bar);
            __builtin_amdgcn_fence(__ATOMIC_ACQUIRE, "agent");
            xb_add(&bar[XB_XGEN(b.x)], 1u);
            asm volatile("s_waitcnt vmcnt(0)" ::: "memory");
        } else {
            XB_SPIN(xb_ld(&bar[XB_XGEN(b.x)]) == gen, bar);
            __builtin_amdgcn_fence(__ATOMIC_ACQUIRE, "agent");
            asm volatile("s_waitcnt vmcnt(0)" ::: "memory");
        }
    }
    __syncthreads();
}

__device__ __forceinline__ float wave_sum(float v) {
    v += __builtin_bit_cast(float, __builtin_amdgcn_update_dpp(0, __builtin_bit_cast(int, v), 0xB1, 0xf, 0xf, true));
    v += __builtin_bit_cast(float, __builtin_amdgcn_update_dpp(0, __builtin_bit_cast(int, v), 0x4E, 0xf, 0xf, true));
    v += __builtin_bit_cast(float, __builtin_amdgcn_update_dpp(0, __builtin_bit_cast(int, v), 0x141, 0xf, 0xf, true));
    v += __builtin_bit_cast(float, __builtin_amdgcn_update_dpp(0, __builtin_bit_cast(int, v), 0x140, 0xf, 0xf, true));
    const int iv = __builtin_bit_cast(int, v);
    const float a = __builtin_bit_cast(float, __builtin_amdgcn_readlane(iv, 0)), b = __builtin_bit_cast(float, __builtin_amdgcn_readlane(iv, 16)),
                c = __builtin_bit_cast(float, __builtin_amdgcn_readlane(iv, 32)), d = __builtin_bit_cast(float, __builtin_amdgcn_readlane(iv, 48));
    return (a + b) + (c + d);
}
__device__ __forceinline__ float sum8(float v) {
    v += __builtin_bit_cast(float, __builtin_amdgcn_update_dpp(0, __builtin_bit_cast(int, v), 0xB1, 0xf, 0xf, true));
    v += __builtin_bit_cast(float, __builtin_amdgcn_update_dpp(0, __builtin_bit_cast(int, v), 0x4E, 0xf, 0xf, true));
    v += __builtin_bit_cast(float, __builtin_amdgcn_update_dpp(0, __builtin_bit_cast(int, v), 0x141, 0xf, 0xf, true));
    return v;
}

struct Ctx {
    LAS unsigned char* lds;
    int tid, lane, wave, vcu, G;
    const float* const* in;
};

__device__ __forceinline__ void transpose_item(const float* W, int K, int N, bf16* WT, int row_off, LAS float* scr, int item, int lane) {
    const int nblk = N / 32, kb = item / nblk, nb = item % nblk, k0 = 64 * kb, n0 = 32 * nb;
#pragma unroll 8
    for (int i = 0; i < 32; ++i) { const int kk = 2 * i + (lane >> 5); scr[kk * 33 + (lane & 31)] = W[(size_t)(k0 + kk) * N + n0 + (lane & 31)]; }
    LDS_WAIT(); asm volatile("" ::: "memory");
    const int c = lane & 7;
#pragma unroll
    for (int j = 0; j < 4; ++j) { const int n = (lane >> 3) + 8 * j; const LAS float* s = scr + (8 * c) * 33 + n;
        v4u o; o.x = pk2(s[0 * 33], s[1 * 33]); o.y = pk2(s[2 * 33], s[3 * 33]); o.z = pk2(s[4 * 33], s[5 * 33]); o.w = pk2(s[6 * 33], s[7 * 33]);
        *(v4u*)(WT + (size_t)(row_off + n0 + n) * K + k0 + 8 * c) = o; }
    LDS_WAIT(); asm volatile("" ::: "memory");
}
__device__ __forceinline__ void transpose_item_gu(const float* W, bf16* WT, int up, LAS float* scr, int item, int lane) {
    const int nblk = DFF / 32, nb = item % nblk, n0 = 32 * nb;
    const int dest0 = (n0 / 128) * 256 + (n0 % 128) + up * 128;
    transpose_item(W, DM, DFF, WT, dest0 - n0, scr, item, lane);
}

struct Args { const float* in[N_IN]; float* out; unsigned char* ws; int ph_lo, ph_hi; };

#define CAS __attribute__((address_space(4)))
#define KARG(ka, i) (*(const float* const CAS*)((ka) + 8 * (i)))
__device__ __forceinline__ void convert_weights(const CAS char* ka, unsigned char* ws, int l, LAS unsigned char* lds, int gw, int NGW, int wave, int lane) {
    LAS float* scr = (LAS float*)(lds + wave * 16384);
    constexpr int I_GU = (DM / 64) * (DFF / 32), I_DN = (DFF / 64) * (DM / 32), I_IN = (DM / 64) * (INC / 32), I_OUT = (DM / 64) * (DM / 32);
    constexpr int NITEMS = 4 * I_GU + 2 * I_DN + I_IN + I_OUT;
    const size_t oGU = (size_t)l * DM * DFF, oIN = (size_t)l * DM * INC, oOUT = (size_t)l * DM * DM;
    for (int it = gw; it < NITEMS; it += NGW) {
        int r = it;
        if (r < I_GU) { transpose_item_gu(KARG(ka, I_F1G) + oGU, (bf16*)(ws + WS_WGU1), 0, scr, r, lane); continue; } r -= I_GU;
        if (r < I_GU) { transpose_item_gu(KARG(ka, I_F1U) + oGU, (bf16*)(ws + WS_WGU1), 1, scr, r, lane); continue; } r -= I_GU;
        if (r < I_GU) { transpose_item_gu(KARG(ka, I_F2G) + oGU, (bf16*)(ws + WS_WGU2), 0, scr, r, lane); continue; } r -= I_GU;
        if (r < I_GU) { transpose_item_gu(KARG(ka, I_F2U) + oGU, (bf16*)(ws + WS_WGU2), 1, scr, r, lane); continue; } r -= I_GU;
        if (r < I_DN) { transpose_item(KARG(ka, I_F1D) + oGU, DFF, DM, (bf16*)(ws + WS_WD1), 0, scr, r, lane); continue; } r -= I_DN;
        if (r < I_DN) { transpose_item(KARG(ka, I_F2D) + oGU, DFF, DM, (bf16*)(ws + WS_WD2), 0, scr, r, lane); continue; } r -= I_DN;
        if (r < I_IN) { transpose_item(KARG(ka, I_WIN) + oIN, DM, INC, (bf16*)(ws + WS_WIN), 0, scr, r, lane); continue; } r -= I_IN;
        transpose_item(KARG(ka, I_WOUT) + oOUT, DM, DM, (bf16*)(ws + WS_WOUT), 0, scr, r, lane);
    }
    { v4u* z = (v4u*)((bf16*)(ws + WS_WIN) + (size_t)INC * DM); const int n16 = (INP - INC) * DM * 2 / 16;
      for (int i = gw * 64 + lane; i < n16; i += NGW * 64) z[i] = (v4u){0u, 0u, 0u, 0u}; }
}

__device__ __forceinline__ void row_phase(const float* xsrc, float* xdst, const bf16* y, const float* gpost, float scale, const float* gnext, bf16* hb, int gw, int NGW, int lane) {
    for (int m = gw; m < M; m += NGW) {
        const f32x4* xr = (const f32x4*)(xsrc + (size_t)m * DM) + lane;
        f32x4 v[4];
#pragma unroll
        for (int j = 0; j < 4; ++j) v[j] = xr[64 * j];
        if (y) {
            const v2u* yr = (const v2u*)(y + (size_t)m * DM) + lane; f32x4 yv[4]; float s = 0.f;
#pragma unroll
            for (int j = 0; j < 4; ++j) { const v2u w = yr[64 * j]; yv[j] = (f32x4){bflo(w.x), bfhi(w.x), bflo(w.y), bfhi(w.y)}; s += (yv[j].x * yv[j].x + yv[j].y * yv[j].y) + (yv[j].z * yv[j].z + yv[j].w * yv[j].w); }
            const float rs = scale * __builtin_amdgcn_rsqf(wave_sum(s) * (1.f / DM) + RMS_EPS);
#pragma unroll
            for (int j = 0; j < 4; ++j) { const f32x4 g = ((const f32x4*)gpost)[64 * j + lane]; v[j] = v[j] + (yv[j] * rs) * g; }
        }
        if (y || xsrc != xdst) { f32x4* xo = (f32x4*)(xdst + (size_t)m * DM) + lane;
#pragma unroll
            for (int j = 0; j < 4; ++j) xo[64 * j] = v[j]; }
        if (gnext) {
            float s2 = 0.f;
#pragma unroll
            for (int j = 0; j < 4; ++j) s2 += (v[j].x * v[j].x + v[j].y * v[j].y) + (v[j].z * v[j].z + v[j].w * v[j].w);
            const float rs2 = __builtin_amdgcn_rsqf(wave_sum(s2) * (1.f / DM) + RMS_EPS);
            v2u* ho = (v2u*)(hb + (size_t)m * DM) + lane;
#pragma unroll
            for (int j = 0; j < 4; ++j) { const f32x4 g = ((const f32x4*)gnext)[64 * j + lane]; const f32x4 h = (v[j] * rs2) * g; v2u w; w.x = pk2(h.x, h.y); w.y = pk2(h.z, h.w); ho[64 * j] = w; }
        }
    }
}

__device__ __forceinline__ void mixA_unit(const bf16* P, const float* scw, bf16* ycat, int unit, int tid) {
    const int b = unit >> 5, t0 = (unit & 31) * 64;
    const int cp = tid & 127, tg = tid >> 7, c = 2 * cp;
    const float w0a = scw[c], w0b = scw[c + 1], w1a = scw[GW + c], w1b = scw[GW + c + 1], w2a = scw[2 * GW + c], w2b = scw[2 * GW + c + 1];
    const int ts = t0 + tg * 16;
    const bf16* prow = P + (size_t)(b * SEQ) * INP + CA;
    unsigned gb[16], gc[18], xa[18];
#pragma unroll
    for (int i = 0; i < 18; ++i) { const int tk = ts - 2 + i;
        if (tk >= 0) { gc[i] = *(const unsigned*)(prow + (size_t)tk * INP + 256 + c); xa[i] = *(const unsigned*)(prow + (size_t)tk * INP + 512 + c); } else { gc[i] = 0u; xa[i] = 0u; } }
#pragma unroll
    for (int i = 0; i < 16; ++i) gb[i] = *(const unsigned*)(prow + (size_t)(ts + i) * INP + c);
    float g2a = bflo(gc[0]) * bflo(xa[0]), g2b = bfhi(gc[0]) * bfhi(xa[0]), g1a = bflo(gc[1]) * bflo(xa[1]), g1b = bfhi(gc[1]) * bfhi(xa[1]);
#pragma unroll
    for (int i = 0; i < 16; ++i) {
        const float g0a = bflo(gc[i + 2]) * bflo(xa[i + 2]), g0b = bfhi(gc[i + 2]) * bfhi(xa[i + 2]);
        const float ya = bflo(gb[i]) * (w0a * g2a + w1a * g1a + w2a * g0a), yb = bfhi(gb[i]) * (w0b * g2b + w1b * g1b + w2b * g0b);
        *(unsigned*)(ycat + (size_t)(b * SEQ + ts + i) * DM + c) = pk2(ya, yb);
        g2a = g1a; g2b = g1b; g1a = g0a; g1b = g0b;
    }
}

__device__ __forceinline__ void mixD_unit(const bf16* P, const float* cw, const float* cb, const float* lnw, const float* lnb, bf16* ycat, LAS unsigned char* lds, int unit, int tid, int wave, int lane) {
    const int b = unit >> 5, t0 = (unit & 31) * 64;
    LAS float* L = (LAS float*)lds;
    const bf16* prow = P + (size_t)(b * SEQ) * INP + CD;
    {
        bf16x8 z1v[6], z2v[6];
#pragma unroll
        for (int q = 0; q < 6; ++q) { const int idx = tid + 512 * q, s = idx >> 5, c8 = (idx & 31) * 8, tok = t0 - 30 + s;
            if (idx < 94 * 32 && tok >= 0) { z1v[q] = *(const bf16x8*)(prow + (size_t)tok * INP + c8); z2v[q] = *(const bf16x8*)(prow + (size_t)tok * INP + 256 + c8); }
            else { for (int e = 0; e < 8; ++e) { z1v[q][e] = 0; z2v[q][e] = 0; } } }
#pragma unroll
        for (int q = 0; q < 6; ++q) { const int idx = tid + 512 * q, s = idx >> 5, c8 = (idx & 31) * 8;
            if (idx < 94 * 32) { float g[8];
#pragma unroll
                for (int e = 0; e < 8; ++e) g[e] = sx(z1v[q][e]) * sigmoid_f(sx(z2v[q][e]));
                *(LAS f32x4*)(L + s * 256 + c8) = (f32x4){g[0], g[1], g[2], g[3]}; *(LAS f32x4*)(L + s * 256 + c8 + 4) = (f32x4){g[4], g[5], g[6], g[7]}; } }
    }
    __syncthreads();
    const int c = tid & 255, tg = tid >> 8;
    float w[31];
#pragma unroll
    for (int j = 0; j < 31; ++j) w[j] = cw[j * GW + c];
    const float bias = cb[c];
    float res[32];
#pragma unroll
    for (int ps = 0; ps < 2; ++ps) {
        float acc[16];
#pragma unroll
        for (int i = 0; i < 16; ++i) acc[i] = bias;
#pragma unroll
        for (int s = 0; s < 46; ++s) {
            const float gv = L[(tg * 32 + ps * 16 + s) * 256 + c];
#pragma unroll
            for (int tt = 0; tt < 16; ++tt) { const int j = s - tt; if (j >= 0 && j <= 30) acc[tt] += w[j] * gv; }
        }
#pragma unroll
        for (int i = 0; i < 16; ++i) res[ps * 16 + i] = acc[i];
        asm volatile("" ::: "memory");
    }
    __syncthreads();
#pragma unroll
    for (int tt = 0; tt < 32; ++tt) L[(tg * 32 + tt) * 256 + c] = res[tt];
    __syncthreads();
    const f32x4 gw4 = ((const f32x4*)lnw)[lane], gb4 = ((const f32x4*)lnb)[lane];
#pragma unroll 2
    for (int i = 0; i < 8; ++i) {
        const int tt = wave * 8 + i; const f32x4 z = *(const LAS f32x4*)(L + tt * 256 + 4 * lane);
        const float mean = wave_sum((z.x + z.y) + (z.z + z.w)) * (1.f / 256.f);
        const f32x4 d = z - mean; const float var = wave_sum((d.x * d.x + d.y * d.y) + (d.z * d.z + d.w * d.w)) * (1.f / 256.f);
        const float rstd = __builtin_amdgcn_rsqf(var + LN_EPS);
        f32x4 o = (d * rstd) * gw4 + gb4; o.x = pg8::silu_f(o.x); o.y = pg8::silu_f(o.y); o.z = pg8::silu_f(o.z); o.w = pg8::silu_f(o.w);
        v2u wv; wv.x = pk2(o.x, o.y); wv.y = pk2(o.z, o.w);
        *(v2u*)(ycat + (size_t)(b * SEQ + t0 + tt) * DM + 768 + 4 * lane) = wv;
    }
    __syncthreads();
}

__device__ __forceinline__ void mixB_unit(const bf16* P, const float* lnw, const float* lnb, const float* sgw, const float* sgb, bf16* ycat, LAS unsigned char* lds, int unit, int tid, int wave, int lane) {
    const int b = unit >> 4, n = unit & 15, tok0 = b * SEQ + n * 128;
    LAS bf16* VT = (LAS bf16*)lds;
    {
        float gwv[4], gbv[4];
#pragma unroll
        for (int e = 0; e < 4; ++e) { gwv[e] = lnw[lane + 64 * e]; gbv[e] = lnb[lane + 64 * e]; }
        unsigned short vin[16][4];
#pragma unroll
        for (int i = 0; i < 16; ++i)
#pragma unroll
            for (int e = 0; e < 4; ++e) vin[i][e] = P[(size_t)(tok0 + wave * 16 + i) * INP + CB + 256 + lane + 64 * e];
#pragma unroll
        for (int i = 0; i < 16; ++i) {
            const int s = wave * 16 + i; float v[4];
#pragma unroll
            for (int e = 0; e < 4; ++e) v[e] = bf2f(vin[i][e]);
            const float mean = wave_sum((v[0] + v[1]) + (v[2] + v[3])) * (1.f / 256.f);
            float q = 0.f;
#pragma unroll
            for (int e = 0; e < 4; ++e) { v[e] -= mean; q += v[e] * v[e]; }
            const float rstd = __builtin_amdgcn_rsqf(wave_sum(q) * (1.f / 256.f) + LN_EPS);
#pragma unroll
            for (int e = 0; e < 4; ++e) VT[(lane + 64 * e) * 136 + s] = (bf16)f2bf((v[e] * rstd) * gwv[e] + gbv[e]);
        }
    }
    __syncthreads();
    const int h = wave >> 1, rh = wave & 1, r = lane & 31, hh = lane >> 5;
#pragma unroll
    for (int ti = 0; ti < 2; ++ti) {
        const int i = ti == 0 ? rh : 3 - rh;
        f32x16 acc0, acc1;
#pragma unroll
        for (int e = 0; e < 16; ++e) { acc0[e] = 0.f; acc1[e] = 0.f; }
        const int nks = 2 * (i + 1), t = 32 * i + r;
        const float* wrow = sgw + ((size_t)h * 128 + t) * 128;
        f32x4 wa[8], wb[8];
#pragma unroll
        for (int ks = 0; ks < 8; ++ks) if (ks < nks) { wa[ks] = *(const f32x4*)(wrow + 16 * ks + 8 * hh); wb[ks] = *(const f32x4*)(wrow + 16 * ks + 8 * hh + 4); }
        unsigned short u0[16], u1[16]; float bs[16];
#pragma unroll
        for (int reg = 0; reg < 16; ++reg) { const int tt = 32 * i + (reg & 3) + 8 * (reg >> 2) + 4 * hh; const size_t tok = (size_t)(tok0 + tt);
            u0[reg] = P[tok * INP + CB + 64 * h + r]; u1[reg] = P[tok * INP + CB + 64 * h + r + 32]; bs[reg] = sgb[h * 128 + tt]; }
#pragma unroll
        for (int ks = 0; ks < 8; ++ks) if (ks < nks) {
            const int s0 = 16 * ks + 8 * hh;
            const float wv[8] = {wa[ks].x, wa[ks].y, wa[ks].z, wa[ks].w, wb[ks].x, wb[ks].y, wb[ks].z, wb[ks].w};
            bf16x8 A;
#pragma unroll
            for (int e = 0; e < 8; ++e) A[e] = (short)f2bf((s0 + e <= t) ? wv[e] : 0.f);
            const bf16x8 B0 = *(const LAS bf16x8*)(VT + (64 * h + r) * 136 + s0), B1 = *(const LAS bf16x8*)(VT + (64 * h + 32 + r) * 136 + s0);
            acc0 = __builtin_amdgcn_mfma_f32_32x32x16_bf16(A, B0, acc0, 0, 0, 0);
            acc1 = __builtin_amdgcn_mfma_f32_32x32x16_bf16(A, B1, acc1, 0, 0, 0);
        }
#pragma unroll
        for (int reg = 0; reg < 16; ++reg) {
            const int tt = 32 * i + (reg & 3) + 8 * (reg >> 2) + 4 * hh; const size_t tok = (size_t)(tok0 + tt);
            const int c0 = 64 * h + r;
            ycat[tok * DM + 256 + c0] = (bf16)f2bf(bf2f(u0[reg]) * (acc0[reg] + bs[reg]));
            ycat[tok * DM + 256 + c0 + 32] = (bf16)f2bf(bf2f(u1[reg]) * (acc1[reg] + bs[reg]));
        }
    }
    __syncthreads();
}

struct RwkvW { const float *mu, *w0, *wup, *a0, *aup, *gup, *kk, *ka, *rk; };
constexpr int XS = 72, NPS = 68;
constexpr int X_AT = 0, X_RT = 9216, X_BT = 18432, X_KT = 27648, X_VT = 36864, X_BH = 46080, X_KH = 55296, X_NP = 64512, X_NK = 81920, X_MB = 91136, X_MK = 100352, X_X2 = 109568,
              X_L = 126976, X_TOT = 143360, X_END = 145408;
constexpr int X_ZT = X_BT;
constexpr int REC_BYTES = 25600;

__device__ __forceinline__ f32x16 mm64(const LAS bf16* PA, const LAS bf16* PB, int r, int hh, f32x16 acc) {
#pragma unroll
    for (int ks = 0; ks < 4; ++ks) {
        const bf16x8 av = *(const LAS bf16x8*)(PA + r * XS + 16 * ks + 8 * hh), bv = *(const LAS bf16x8*)(PB + r * XS + 16 * ks + 8 * hh);
        acc = __builtin_amdgcn_mfma_f32_32x32x16_bf16(av, bv, acc, 0, 0, 0);
    }
    return acc;
}
typedef __bf16 bf16x2v __attribute__((ext_vector_type(2)));
__device__ __forceinline__ float dot2(unsigned a, unsigned b, float c) { return __builtin_amdgcn_fdot2_f32_bf16(__builtin_bit_cast(bf16x2v, a), __builtin_bit_cast(bf16x2v, b), c, false); }
__device__ __forceinline__ float quad_sum(float v) {
    v += __builtin_bit_cast(float, __builtin_amdgcn_update_dpp(0, __builtin_bit_cast(int, v), 0xB1, 0xf, 0xf, true));
    v += __builtin_bit_cast(float, __builtin_amdgcn_update_dpp(0, __builtin_bit_cast(int, v), 0x4E, 0xf, 0xf, true));
    return v;
}
#define WG_BAR() do { asm volatile("s_waitcnt lgkmcnt(0)" ::: "memory"); __builtin_amdgcn_s_barrier(); asm volatile("" ::: "memory"); } while (0)

__device__ __forceinline__ void rwkv_chunk_unit(const bf16* P, const RwkvW& W, unsigned char* ws, LAS unsigned char* lds, int unit, int tid, int wave, int lane) {
    const int b = unit >> 5, cidx = unit & 31, t0 = cidx * 64;
    const bf16* prow = P + (size_t)(b * SEQ) * INP + CC;
    LAS bf16* Lb = (LAS bf16*)(lds + X_L);
    {
        bf16x8 cu[2], pv[2];
#pragma unroll
        for (int q = 0; q < 2; ++q) { const int idx = tid + 512 * q, tt = idx >> 4, j0 = (idx & 15) * 8, tok = t0 + tt;
            cu[q] = *(const bf16x8*)(prow + (size_t)tok * INP + 768 + j0);
            if (tok > 0) pv[q] = *(const bf16x8*)(prow + (size_t)(tok - 1) * INP + 768 + j0); else { for (int e = 0; e < 8; ++e) pv[q][e] = 0; } }
#pragma unroll
        for (int q = 0; q < 2; ++q) { const int idx = tid + 512 * q, tt = idx >> 4, j0 = (idx & 15) * 8;
            const f32x4 m0 = *(const f32x4*)(W.mu + 768 + j0), m1 = *(const f32x4*)(W.mu + 768 + j0 + 4); const float mu8[8] = {m0.x, m0.y, m0.z, m0.w, m1.x, m1.y, m1.z, m1.w};
            float o[8];
#pragma unroll
            for (int e = 0; e < 8; ++e) { const float cur = sx(cu[q][e]), prev = sx(pv[q][e]); const float xs = cur + (prev - cur) * mu8[e];
                o[e] = (j0 < 32) ? (1.0f - 2.0f * __builtin_amdgcn_rcpf(1.0f + fexp(2.0f * xs))) : (j0 < 64) ? xs : sigmoid_f(xs); }
            v4u w; w.x = pk2(o[0], o[1]); w.y = pk2(o[2], o[3]); w.z = pk2(o[4], o[5]); w.w = pk2(o[6], o[7]);
            *(LAS v4u*)(Lb + tt * 128 + j0) = w; }
    }
    __syncthreads();
    const int tg = wave;
    LAS bf16* PAt = (LAS bf16*)(lds + X_AT); LAS bf16* PRt = (LAS bf16*)(lds + X_RT); LAS bf16* PBt = (LAS bf16*)(lds + X_BT); LAS bf16* PKt = (LAS bf16*)(lds + X_KT);
    LAS bf16* PVT = (LAS bf16*)(lds + X_VT); LAS bf16* PBH = (LAS bf16*)(lds + X_BH); LAS bf16* PKH = (LAS bf16*)(lds + X_KH);
    LAS float* PNP = (LAS float*)(lds + X_NP); LAS bf16* PNK = (LAS bf16*)(lds + X_NK); LAS bf16* PMB = (LAS bf16*)(lds + X_MB); LAS bf16* PMK = (LAS bf16*)(lds + X_MK);
    LAS float* PX2 = (LAS float*)(lds + X_X2); LAS float* PTOT = (LAS float*)(lds + X_TOT); LAS bf16* PZT = (LAS bf16*)(lds + X_ZT);
    bf16* Vg = (bf16*)(ws + WS_V); bf16* Gg = (bf16*)(ws + WS_G); float* Bon = (float*)(ws + WS_BONUS);
#pragma nounroll
    for (int h = 0; h < NH; ++h) {
        int tidh = tid; asm volatile("" : "+v"(tidh));
        const int c = tidh & 63, r = tidh & 31, hh = (tidh >> 5) & 1;
        const int ch = 64 * h + c;
        const size_t rc = (size_t)((b * NH + h) * 32 + cidx);
        unsigned char* rec = ws + WS_REC + rc * REC_BYTES;
        const size_t tokb = (size_t)(b * SEQ + t0 + 8 * tg);
        const int ts = t0 + 8 * tg;
        unsigned wup2[16], aup2[16], gup2[32];
#pragma unroll
        for (int j = 0; j < 16; ++j) { wup2[j] = pg8::cvt_pk_bf16(W.wup[(2 * j) * GW + ch], W.wup[(2 * j + 1) * GW + ch]); aup2[j] = pg8::cvt_pk_bf16(W.aup[(2 * j) * GW + ch], W.aup[(2 * j + 1) * GW + ch]); }
#pragma unroll
        for (int j = 0; j < 32; ++j) gup2[j] = pg8::cvt_pk_bf16(W.gup[(2 * j) * GW + ch], W.gup[(2 * j + 1) * GW + ch]);
        unsigned short xr9[9], xk9[9], xv9[9];
        { const bf16* q0 = prow + (size_t)(ts > 0 ? ts - 1 : 0) * INP + ch;
          xr9[0] = q0[0]; xk9[0] = q0[256]; xv9[0] = q0[512];
          if (ts == 0) { xr9[0] = 0; xk9[0] = 0; xv9[0] = 0; }
          const bf16* q1 = prow + (size_t)ts * INP + ch;
#pragma unroll
          for (int i = 0; i < 8; ++i) { xr9[i + 1] = q1[i * INP]; xk9[i + 1] = q1[i * INP + 256]; xv9[i + 1] = q1[i * INP + 512]; } }
        const float w0 = W.w0[ch], mur = W.mu[ch], muk = W.mu[256 + ch], muv = W.mu[512 + ch], a0 = W.a0[ch], kkc = W.kk[ch], kac = W.ka[ch], rkc = W.rk[ch];
        float lw8[8];
        {
#pragma unroll
            for (int i = 0; i < 8; ++i) {
                const LAS v4u* Lr = (const LAS v4u*)(Lb + (8 * tg + i) * 128);
                float z0 = w0, z1 = 0.f;
#pragma unroll
                for (int q = 0; q < 4; ++q) { const v4u x = Lr[q]; z0 = dot2(x.x, wup2[4 * q], z0); z1 = dot2(x.y, wup2[4 * q + 1], z1); z0 = dot2(x.z, wup2[4 * q + 2], z0); z1 = dot2(x.w, wup2[4 * q + 3], z1); }
                const float nz = -(z0 + z1); const float sp = fmaxf(nz, 0.f) + 0.6931471805599453f * __builtin_amdgcn_logf(1.0f + fexp(-fabsf(nz)));
                lw8[i] = -fexp(-sp - 0.5f);
            }
        }
        float lc[8]; { float run = 0.f;
#pragma unroll
            for (int i = 0; i < 8; ++i) { run += lw8[i]; lc[i] = run; } }
        PTOT[tg * 64 + c] = lc[7];
        WG_BAR();
        float off = 0.f, ltot = 0.f;
#pragma unroll
        for (int g = 0; g < 8; ++g) { const float tv = PTOT[g * 64 + c]; ltot += tv; off += (g < tg) ? tv : 0.f; }
        if (tg == 0) ((float*)(rec + 24576))[c] = fexp(ltot);
        {
#pragma unroll
            for (int i = 0; i < 8; ++i) {
                const LAS v4u* Lr = (const LAS v4u*)(Lb + (8 * tg + i) * 128 + 64);
                float g0 = 0.f, g1 = 0.f;
#pragma unroll
                for (int q = 0; q < 8; ++q) { const v4u x = Lr[q]; g0 = dot2(x.x, gup2[4 * q], g0); g1 = dot2(x.y, gup2[4 * q + 1], g1); g0 = dot2(x.z, gup2[4 * q + 2], g0); g1 = dot2(x.w, gup2[4 * q + 3], g1); }
                Gg[(tokb + i) * GW + ch] = (bf16)pg8::cvt_pk_bf16(g0 + g1, 0.f);
            }
        }
        {
#pragma unroll
            for (int i = 0; i < 8; ++i) {
                const float cr = bf2f(xr9[i + 1]), ck = bf2f(xk9[i + 1]), cv = bf2f(xv9[i + 1]), pr = bf2f(xr9[i]), pk = bf2f(xk9[i]), pv = bf2f(xv9[i]);
                const float rr = cr + (pr - cr) * mur, k = ck + (pk - ck) * muk, v = cv + (pv - cv) * muv;
                const LAS v4u* Lr = (const LAS v4u*)(Lb + (8 * tg + i) * 128 + 32);
                float z0 = a0, z1 = 0.f;
#pragma unroll
                for (int q = 0; q < 4; ++q) { const v4u x = Lr[q]; z0 = dot2(x.x, aup2[4 * q], z0); z1 = dot2(x.y, aup2[4 * q + 1], z1); z0 = dot2(x.z, aup2[4 * q + 2], z0); z1 = dot2(x.w, aup2[4 * q + 3], z1); }
                const float asig = sigmoid_f(z0 + z1);
                float kk = k * kkc; kk = kk * __builtin_amdgcn_rsqf(fmaxf(wave_sum(kk * kk), 1e-24f));
                const float k2 = k * (1.f + (asig - 1.f) * kac);
                const float bon = wave_sum(rr * k2 * rkc);
                const unsigned prk = pg8::cvt_pk_bf16(rr, k2), pkb = pg8::cvt_pk_bf16(kk, kk * asig);
                const float rq = bflo(prk), kq = bfhi(prk), kkq = bflo(pkb), bq = bfhi(pkb);
                const unsigned vq = pg8::cvt_pk_bf16(v, v) & 0xffffu;
                Vg[(tokb + i) * GW + ch] = (bf16)vq;
                if ((tidh & 63) == 0) Bon[(tokb + i) * NH + h] = bon;
                const int t = 8 * tg + i; const float Lt = off + lc[i], Lm = Lt - lw8[i];
                const float eL = fexp(Lt), eLm = fexp(Lm), enL = fexp(-Lt), eCL = fexp(ltot - Lt);
                { const unsigned w1 = pg8::cvt_pk_bf16(-kkq * eLm, rq * eL), w2 = pg8::cvt_pk_bf16(bq * enL, kq * enL);
                  PAt[t * XS + c] = (bf16)w1; PRt[t * XS + c] = (bf16)(w1 >> 16); PBt[t * XS + c] = (bf16)w2; PKt[t * XS + c] = (bf16)(w2 >> 16); }
                { const unsigned w3 = pg8::cvt_pk_bf16(bq * eCL, kq * eCL); PVT[c * XS + t] = (bf16)vq; PBH[c * XS + t] = (bf16)w3; PKH[c * XS + t] = (bf16)(w3 >> 16); }
            }
        }
        WG_BAR();
        {
            const int prod = wave >> 1, nt = wave & 1, t = 32 * nt + r;
            const LAS bf16* PA = (prod & 1) ? PKt : PBt; const LAS bf16* PB = (prod >> 1) ? PRt : PAt;
#pragma unroll
            for (int mt = 0; mt < 2; ++mt) {
                f32x16 acc;
#pragma unroll
                for (int e = 0; e < 16; ++e) acc[e] = 0.f;
                if (mt <= nt) acc = mm64(PA + 32 * mt * XS, PB + 32 * nt * XS, r, hh, acc);
#pragma unroll
                for (int g = 0; g < 4; ++g) {
                    const int tau0 = 32 * mt + 8 * g + 4 * hh; float vv[4];
#pragma unroll
                    for (int e = 0; e < 4; ++e) { const int tau = tau0 + e; const bool keep = (prod >= 2) ? (tau <= t) : (tau < t); vv[e] = keep ? acc[4 * g + e] : 0.f; }
                    if (prod == 0) {
#pragma unroll
                        for (int e = 0; e < 4; ++e) PNP[t * NPS + e * 16 + (8 * mt + 2 * g + hh)] = vv[e];
                    } else {
                        LAS bf16* PD = (prod == 1) ? PNK : (prod == 2) ? PMB : PMK;
                        v2u w; w.x = pk2(vv[0], vv[1]); w.y = pk2(vv[2], vv[3]); *(LAS v2u*)(PD + t * XS + tau0) = w;
                    }
                }
            }
        }
        WG_BAR();
        if (wave < 4) {
            const int mt = wave >> 1, nt = wave & 1, t = 32 * nt + r;
            f32x16 acc;
#pragma unroll
            for (int e = 0; e < 16; ++e) acc[e] = 0.f;
            acc = mm64(PVT + 32 * mt * XS, PNK + 32 * nt * XS, r, hh, acc);
#pragma unroll
            for (int g = 0; g < 4; ++g) *(LAS f32x4*)(PX2 + t * NPS + 32 * mt + 8 * g + 4 * hh) = (f32x4){acc[4 * g], acc[4 * g + 1], acc[4 * g + 2], acc[4 * g + 3]};
        }
        WG_BAR();
        {
            const int col = tidh >> 2, s = tidh & 3;
            float xr[16], zr[16];
#pragma unroll
            for (int m = 0; m < 16; ++m) { zr[m] = 0.f; xr[m] = (col < 64) ? bf2f(PAt[(4 * m + s) * XS + col]) : PX2[(4 * m + s) * NPS + (col - 64)]; }
#pragma unroll
            for (int t = 0; t < 64; ++t) {
                const int nm = (t + 3) >> 2, ml = (t - 1) >> 2;
                float nvv[16];
#pragma unroll
                for (int m4 = 0; m4 < (nm + 3) / 4; ++m4) { const f32x4 nv = *(const LAS f32x4*)(PNP + t * NPS + s * 16 + 4 * m4); nvv[4 * m4] = nv.x; nvv[4 * m4 + 1] = nv.y; nvv[4 * m4 + 2] = nv.z; nvv[4 * m4 + 3] = nv.w; }
                float pa[4] = {(s == (t & 3)) ? xr[t >> 2] : 0.f, 0.f, 0.f, 0.f};
#pragma unroll
                for (int m = 0; m < nm; ++m) if (m != ml) pa[m & 3] += nvv[m] * zr[m];
                float p = (pa[0] + pa[1]) + (pa[2] + pa[3]);
                if (t > 0) p += nvv[ml] * zr[ml];
                const float tot = quad_sum(p);
                zr[t >> 2] = (s == (t & 3)) ? tot : zr[t >> 2];
            }
#pragma unroll
            for (int m = 0; m < 16; m += 2) { const unsigned w = pg8::cvt_pk_bf16(zr[m], zr[m + 1]); PZT[col * XS + 4 * m + s] = (bf16)w; PZT[col * XS + 4 * m + 4 + s] = (bf16)(w >> 16); }
        }
        WG_BAR();
        {
            const int tl = wave & 3, mt = tl >> 1, nt = tl & 1;
            f32x16 acc;
#pragma unroll
            for (int e = 0; e < 16; ++e) acc[e] = 0.f;
            if (wave < 4) {
                acc = mm64(PZT + (64 + 32 * mt) * XS, PMB + 32 * nt * XS, r, hh, acc);
                acc = mm64(PVT + 32 * mt * XS, PMK + 32 * nt * XS, r, hh, acc);
                float* hy = (float*)(ws + WS_HYV) + rc * 4096;
#pragma unroll
                for (int g = 0; g < 4; ++g) *(f32x4*)(hy + ((tl * 4 + g) * 64 + (tidh & 63)) * 4) = (f32x4){acc[4 * g], acc[4 * g + 1], acc[4 * g + 2], acc[4 * g + 3]};
#pragma unroll
                for (int e = 0; e < 16; ++e) acc[e] = 0.f;
                acc = mm64(PZT + 32 * mt * XS, PMB + 32 * nt * XS, r, hh, acc);
                bf16* gy = (bf16*)(ws + WS_GY) + rc * 4096; const int t = 32 * nt + r;
#pragma unroll
                for (int g = 0; g < 4; ++g) { const int j0 = 32 * mt + 8 * g + 4 * hh; const v2u rv = *(const LAS v2u*)(PRt + t * XS + j0);
                    v2u w; w.x = pk2(acc[4 * g] + bflo(rv.x), acc[4 * g + 1] + bfhi(rv.x)); w.y = pk2(acc[4 * g + 2] + bflo(rv.y), acc[4 * g + 3] + bfhi(rv.y)); *(v2u*)(gy + t * 64 + j0) = w; }
            } else {
                acc = mm64(PBH + 32 * mt * XS, PZT + (64 + 32 * nt) * XS, r, hh, acc);
                acc = mm64(PKH + 32 * mt * XS, PVT + 32 * nt * XS, r, hh, acc);
#pragma unroll
                for (int g = 0; g < 4; ++g) *(f32x4*)(rec + 8192 + ((tl * 4 + g) * 64 + (tidh & 63)) * 16) = (f32x4){acc[4 * g], acc[4 * g + 1], acc[4 * g + 2], acc[4 * g + 3]};
#pragma unroll
                for (int e = 0; e < 16; ++e) acc[e] = 0.f;
                acc = mm64(PZT + 32 * mt * XS, PBH + 32 * nt * XS, r, hh, acc);
#pragma unroll
                for (int g = 0; g < 4; ++g) { const int f = (nt * 2 + mt) * 2 + (g >> 1);
                    v2u w; w.x = pk2(acc[4 * g], acc[4 * g + 1]); w.y = pk2(acc[4 * g + 2], acc[4 * g + 3]); *(v2u*)(rec + f * 1024 + (tidh & 63) * 16 + (g & 1) * 8) = w; }
            }
        }
        WG_BAR();
    }
}

__device__ __forceinline__ void dma_record(const unsigned char* g, LAS unsigned char* slot, int lane) {
#pragma unroll
    for (int k = 0; k < REC_BYTES / 1024; ++k) __builtin_amdgcn_global_load_lds((const unsigned*)(g + k * 1024 + lane * 16), (LAS unsigned*)(slot + k * 1024), 16, 0, 0);
}
__device__ __forceinline__ void rwkv_scan_unit(unsigned char* ws, LAS unsigned char* lds, int bh, int wave, int lane) {
    const unsigned char* recs = ws + WS_REC + (size_t)bh * 32 * REC_BYTES;
    bf16* st0 = (bf16*)(ws + WS_ST0) + (size_t)bh * 32 * 4096;
    const int r = lane & 31, hh = lane >> 5;
    const bool compute = (wave == 0 || wave == 6); const int ct = (wave == 6) ? 1 : 0;
    if (wave >= 1 && wave <= 5) dma_record(recs + (size_t)(wave - 1) * REC_BYTES, lds + (wave - 1) * REC_BYTES, lane);
    f32x16 S[2];
#pragma unroll
    for (int a = 0; a < 2; ++a)
#pragma unroll
        for (int e = 0; e < 16; ++e) S[a][e] = 0.f;
#pragma nounroll
    for (int c = 0; c < 32; ++c) {
        const int sl = c % 5;
        if (wave == 1 + sl) asm volatile("s_waitcnt vmcnt(0)" ::: "memory");
        asm volatile("s_waitcnt lgkmcnt(0)" ::: "memory"); __builtin_amdgcn_s_barrier(); asm volatile("" ::: "memory");
        if (compute) {
            const LAS unsigned char* slot = lds + sl * REC_BYTES;
            bf16* so = st0 + (size_t)c * 4096;
            typedef unsigned u32x4v __attribute__((ext_vector_type(4)));
            bf16x8 Bf[2][2];
#pragma unroll
            for (int jt = 0; jt < 2; ++jt)
#pragma unroll
                for (int s2 = 0; s2 < 2; ++s2) { u32x4v w;
                    w.x = pg8::cvt_pk_bf16(S[jt][8 * s2 + 0], S[jt][8 * s2 + 1]); w.y = pg8::cvt_pk_bf16(S[jt][8 * s2 + 2], S[jt][8 * s2 + 3]);
                    w.z = pg8::cvt_pk_bf16(S[jt][8 * s2 + 4], S[jt][8 * s2 + 5]); w.w = pg8::cvt_pk_bf16(S[jt][8 * s2 + 6], S[jt][8 * s2 + 7]);
                    Bf[jt][s2] = __builtin_bit_cast(bf16x8, w);
                    *(v2u*)(so + (32 * ct + r) * 64 + 32 * jt + 16 * s2 + 4 * hh) = (v2u){w.x, w.y};
                    *(v2u*)(so + (32 * ct + r) * 64 + 32 * jt + 16 * s2 + 8 + 4 * hh) = (v2u){w.z, w.w}; }
            f32x16 Sn[2];
#pragma unroll
            for (int jo = 0; jo < 2; ++jo) {
                f32x16 acc;
#pragma unroll
                for (int g = 0; g < 4; ++g) { const f32x4 wc = *(const LAS f32x4*)(slot + 24576 + (32 * jo + 8 * g + 4 * hh) * 4);
                    const f32x4 nv = *(const LAS f32x4*)(slot + 8192 + (((jo * 2 + ct) * 4 + g) * 64 + lane) * 16);
#pragma unroll
                    for (int e = 0; e < 4; ++e) acc[4 * g + e] = nv[e] + wc[e] * S[jo][4 * g + e]; }
#pragma unroll
                for (int jt = 0; jt < 2; ++jt)
#pragma unroll
                    for (int s2 = 0; s2 < 2; ++s2) { const bf16x8 av = *(const LAS bf16x8*)(slot + ((jo * 2 + jt) * 2 + s2) * 1024 + lane * 16);
                        acc = __builtin_amdgcn_mfma_f32_32x32x16_bf16(av, Bf[jt][s2], acc, 0, 0, 0); }
                Sn[jo] = acc;
            }
            S[0] = Sn[0]; S[1] = Sn[1];
        } else if (c >= 1 && c + 4 < 32 && wave == 1 + ((c + 4) % 5)) {
            dma_record(recs + (size_t)(c + 4) * REC_BYTES, lds + ((c + 4) % 5) * REC_BYTES, lane);
        }
    }
    asm volatile("s_waitcnt vmcnt(0) lgkmcnt(0)" ::: "memory"); __builtin_amdgcn_s_barrier(); asm volatile("" ::: "memory");
}

__device__ __forceinline__ void rwkv_out_unit(const unsigned char* ws, const float* lnw, const float* lnb, bf16* ycat, int unit, int wave, int lane) {
    const int b = unit >> 5, cidx = unit & 31, h = wave >> 1, nt = wave & 1, r = lane & 31, hh = lane >> 5;
    const size_t rc = (size_t)((b * NH + h) * 32 + cidx);
    const bf16* st0 = (const bf16*)(ws + WS_ST0) + rc * 4096; const bf16* gy = (const bf16*)(ws + WS_GY) + rc * 4096; const float* hy = (const float*)(ws + WS_HYV) + rc * 4096;
    const bf16* Vg = (const bf16*)(ws + WS_V); const bf16* Gg = (const bf16*)(ws + WS_G); const float* Bon = (const float*)(ws + WS_BONUS);
    const size_t tok = (size_t)(b * SEQ + cidx * 64 + 32 * nt + r);
    const float bon = Bon[tok * NH + h];
    v2u vvp[2][4], ggp[2][4]; f32x4 hyv[2][4]; bf16x8 avv[2][4], bvv[4];
#pragma unroll
    for (int ks = 0; ks < 4; ++ks) bvv[ks] = *(const bf16x8*)(gy + (32 * nt + r) * 64 + 16 * ks + 8 * hh);
#pragma unroll
    for (int mt = 0; mt < 2; ++mt)
#pragma unroll
        for (int g = 0; g < 4; ++g) { const int i0 = 64 * h + 32 * mt + 8 * g + 4 * hh;
            hyv[mt][g] = *(const f32x4*)(hy + (((mt * 2 + nt) * 4 + g) * 64 + lane) * 4); avv[mt][g] = *(const bf16x8*)(st0 + (32 * mt + r) * 64 + 16 * g + 8 * hh);
            vvp[mt][g] = *(const v2u*)(Vg + tok * GW + i0); ggp[mt][g] = *(const v2u*)(Gg + tok * GW + i0); }
    f32x16 acc[2];
#pragma unroll
    for (int mt = 0; mt < 2; ++mt) {
#pragma unroll
        for (int g = 0; g < 4; ++g) { acc[mt][4 * g] = hyv[mt][g].x; acc[mt][4 * g + 1] = hyv[mt][g].y; acc[mt][4 * g + 2] = hyv[mt][g].z; acc[mt][4 * g + 3] = hyv[mt][g].w; }
#pragma unroll
        for (int ks = 0; ks < 4; ++ks) acc[mt] = __builtin_amdgcn_mfma_f32_32x32x16_bf16(avv[mt][ks], bvv[ks], acc[mt], 0, 0, 0);
    }
    float s1 = 0.f;
#pragma unroll
    for (int mt = 0; mt < 2; ++mt)
#pragma unroll
        for (int e = 0; e < 16; ++e) s1 += acc[mt][e];
    s1 += __shfl_xor(s1, 32);
    const float mean = s1 * (1.f / 64.f); float s2 = 0.f;
#pragma unroll
    for (int mt = 0; mt < 2; ++mt)
#pragma unroll
        for (int e = 0; e < 16; ++e) { const float d = acc[mt][e] - mean; s2 += d * d; }
    s2 += __shfl_xor(s2, 32);
    const float rstd = __builtin_amdgcn_rsqf(s2 * (1.f / 64.f) + GN_EPS);
#pragma unroll
    for (int mt = 0; mt < 2; ++mt)
#pragma unroll
        for (int g = 0; g < 4; ++g) {
            const int i0 = 64 * h + 32 * mt + 8 * g + 4 * hh;
            const f32x4 gw = *(const f32x4*)(lnw + i0), gb = *(const f32x4*)(lnb + i0);
            const v2u vv = vvp[mt][g], gg = ggp[mt][g];
            const float o0 = ((acc[mt][4 * g] - mean) * rstd * gw.x + gb.x + bon * bflo(vv.x)) * bflo(gg.x);
            const float o1 = ((acc[mt][4 * g + 1] - mean) * rstd * gw.y + gb.y + bon * bfhi(vv.x)) * bfhi(gg.x);
            const float o2 = ((acc[mt][4 * g + 2] - mean) * rstd * gw.z + gb.z + bon * bflo(vv.y)) * bflo(gg.y);
            const float o3 = ((acc[mt][4 * g + 3] - mean) * rstd * gw.w + gb.w + bon * bfhi(vv.y)) * bfhi(gg.y);
            v2u w; w.x = pk2(o0, o1); w.y = pk2(o2, o3);
            *(v2u*)(ycat + tok * DM + 512 + i0) = w;
        }
}

constexpr int PH_PER_LAYER = 12, N_PHASES = 1 + DEPTH * PH_PER_LAYER;
__global__ void __launch_bounds__(NWAVES * 64, 2) mega_fwd(Args args) {
    extern __shared__ __attribute__((aligned(16))) unsigned char lds_raw[];
    LAS unsigned char* lds = (LAS unsigned char*)lds_raw;
    const CAS char* ka0 = (const CAS char*)__builtin_amdgcn_kernarg_segment_ptr();
    unsigned char* ws0 = *(unsigned char* const CAS*)(ka0 + 8 * (N_IN + 1));
    volatile LAS unsigned* MISC = (volatile LAS unsigned*)(lds + MISC_OFF);
    for (int u = threadIdx.x; u < (LDS_BYTES - LDSCTL_OFF) / 4; u += NWAVES * 64) ((LAS unsigned*)(lds + LDSCTL_OFF))[u] = 0u;
    __syncthreads();
    XcdBarrier bar; bar.bar = (unsigned*)(ws0 + WS_CTL) + CW_BAR; bar.x = 0; bar.st = nullptr;
    if (MK_ONE_LAUNCH) bar = xcd_barrier_post((unsigned*)(ws0 + WS_CTL) + CW_BAR, MISC + 8);
    const int lo = *(const int CAS*)(ka0 + 8 * (N_IN + 2)), hi = *(const int CAS*)(ka0 + 8 * (N_IN + 2) + 4);
#define IN(k) (lo <= (k) && (k) < hi)
#define SEAM(k) do { if (MK_ONE_LAUNCH && IN(k) && IN((k) + 1)) xcd_barrier(bar); } while (0)
#define PHASE_PROLOGUE() \
        const CAS char* ka = ka0; asm volatile("" : "+s"(ka)); unsigned char* ws = ws0; asm volatile("" : "+s"(ws)); \
        int G = gridDim.x, bx = blockIdx.x; asm volatile("" : "+s"(G), "+s"(bx)); \
        const int vcu = (G % 8 == 0) ? (bx % 8) * (G / 8) + bx / 8 : bx, NGW = G * NWAVES; \
        int tid = threadIdx.x; asm volatile("" : "+v"(tid)); const int lane = tid & 63, wave = __builtin_amdgcn_readfirstlane(tid >> 6), gw = vcu * NWAVES + wave; \
        float* X = *(float* const CAS*)(ka + 8 * N_IN); bf16* HB = (bf16*)(ws + WS_HB); bf16* PH = (bf16*)(ws + WS_PH); bf16* Y = (bf16*)(ws + WS_Y); bf16* YCAT = HB; \
        (void)vcu; (void)NGW; (void)lane; (void)gw; (void)X; (void)PH; (void)Y; (void)YCAT;
#define GEMM_SWIGLU(WOFF) do { PHASE_PROLOGUE(); pg8::Gemm g{HB, (const bf16*)(ws + (WOFF)), M, 2 * DFF, DM}; pg8::StaticOrder S; S.init(M, 2 * DFF, G, bx); pg8::EpiSwiGLU E{PH, DFF}; \
        for (int rep = 0; rep < REP_GEMM; ++rep) pg8::gemm_phase<pg8::EpiSwiGLU, pg8::StaticOrder, true, true>(lds, g, S, E, tid); } while (0)
#define GEMM_BF16(A_, WOFF, N_, K_, O_) do { PHASE_PROLOGUE(); pg8::Gemm g{(A_), (const bf16*)(ws + (WOFF)), M, (N_), (K_)}; pg8::StaticOrder S; S.init(M, (N_), G, bx); pg8::EpiBf16 E{(O_), (N_)}; \
        for (int rep = 0; rep < REP_GEMM; ++rep) pg8::gemm_phase<pg8::EpiBf16, pg8::StaticOrder, true, true>(lds, g, S, E, tid); } while (0)
#define ROWS(GPOST, SCALE, GNEXT) do { row_phase(X, X, Y, (GPOST), (SCALE), (GNEXT), HB, gw, NGW, lane); } while (0)

    if (IN(0)) { PHASE_PROLOGUE();
        for (int rep = 0; rep < REP_CONV; ++rep) convert_weights(ka, ws, 0, lds, gw, NGW, wave, lane);
        row_phase(KARG(ka, I_X), X, nullptr, nullptr, 0.f, KARG(ka, I_F1PRE), HB, gw, NGW, lane); }
    SEAM(0);
#define LAYER(l, pb) \
    if (IN(pb + 0)) GEMM_SWIGLU(WS_WGU1);                                    \
    SEAM(pb + 0); \
    if (IN(pb + 1)) GEMM_BF16(PH, WS_WD1, DM, DFF, Y);                       \
    SEAM(pb + 1); \
    if (IN(pb + 2)) { PHASE_PROLOGUE(); ROWS(KARG(ka, I_F1POST) + l * DM, 0.5f, KARG(ka, I_MIXPRE) + l * DM); }     \
    SEAM(pb + 2); \
    if (IN(pb + 3)) GEMM_BF16(HB, WS_WIN, INP, DM, PH);                      \
    SEAM(pb + 3); \
    if (IN(pb + 4)) { PHASE_PROLOGUE();                                      \
        for (int rep = 0; rep < REP_MIX; ++rep) \
        for (int u = vcu; u < 256 + 256 + 128 + 256; u += G) { \
            const CAS char* ka = ka0; asm volatile("" : "+s"(ka)); unsigned char* ws = ws0; asm volatile("" : "+s"(ws)); bf16* PH = (bf16*)(ws + WS_PH); bf16* YCAT = (bf16*)(ws + WS_HB); \
            int tid = threadIdx.x; asm volatile("" : "+v"(tid)); const int lane = tid & 63, wave = __builtin_amdgcn_readfirstlane(tid >> 6); \
            if (u < 256) { \
                RwkvW RW{KARG(ka, I_MU) + l * 896, KARG(ka, I_W0) + l * GW, KARG(ka, I_WUP) + l * 32 * GW, KARG(ka, I_A0) + l * GW, KARG(ka, I_AUP) + l * 32 * GW, KARG(ka, I_GUP) + l * 64 * GW, \
                         KARG(ka, I_KK) + l * GW, KARG(ka, I_KA) + l * GW, KARG(ka, I_RK) + l * GW}; \
                for (int q = 0; q < REP_CH; ++q) rwkv_chunk_unit(PH, RW, ws, lds, u, tid, wave, lane); } \
            else if (u < 512) { for (int q = 0; q < REP_D; ++q) mixD_unit(PH, KARG(ka, I_CMW) + l * 31 * GW, KARG(ka, I_CMB) + l * GW, KARG(ka, I_CMLNW) + l * GW, KARG(ka, I_CMLNB) + l * GW, YCAT, lds, u - 256, tid, wave, lane); } \
            else if (u < 640) { for (int q = 0; q < REP_B; ++q) mixB_unit(PH, KARG(ka, I_SGLNW) + l * GW, KARG(ka, I_SGLNB) + l * GW, KARG(ka, I_SGW) + (size_t)l * NH * 128 * 128, KARG(ka, I_SGB) + l * NH * 128, YCAT, lds, u - 512, tid, wave, lane); } \
            else { for (int q = 0; q < REP_A; ++q) mixA_unit(PH, KARG(ka, I_SCW) + l * 3 * GW, YCAT, u - 640, tid); } \
        } } \
    SEAM(pb + 4); \
    if (IN(pb + 5)) { PHASE_PROLOGUE();                                      \
        for (int rep = 0; rep < REP_X2; ++rep) for (int u = vcu; u < BATCH * NH; u += G) rwkv_scan_unit(ws, lds, u, wave, lane); } \
    SEAM(pb + 5); \
    if (IN(pb + 6)) { PHASE_PROLOGUE();                                      \
        for (int rep = 0; rep < REP_X3; ++rep) for (int u = vcu; u < M / 64; u += G) rwkv_out_unit(ws, KARG(ka, I_RLNW) + l * GW, KARG(ka, I_RLNB) + l * GW, YCAT, u, wave, lane); } \
    SEAM(pb + 6); \
    if (IN(pb + 7)) GEMM_BF16(YCAT, WS_WOUT, DM, DM, Y);                     \
    SEAM(pb + 7); \
    if (IN(pb + 8)) { PHASE_PROLOGUE(); ROWS(KARG(ka, I_MIXPOST) + l * DM, 1.0f, KARG(ka, I_F2PRE) + l * DM); }     \
    SEAM(pb + 8); \
    if (IN(pb + 9)) GEMM_SWIGLU(WS_WGU2);                                    \
    SEAM(pb + 9); \
    if (IN(pb + 10)) GEMM_BF16(PH, WS_WD2, DM, DFF, Y);                      \
    SEAM(pb + 10); \
    if (IN(pb + 11)) { PHASE_PROLOGUE();                                     \
        if (l + 1 < DEPTH) { for (int rep = 0; rep < REP_CONV; ++rep) convert_weights(ka, ws, l + 1, lds, gw, NGW, wave, lane); } \
        ROWS(KARG(ka, I_F2POST) + l * DM, 0.5f, (l + 1 < DEPTH) ? KARG(ka, I_F1PRE) + (l + 1) * DM : nullptr); } \
    SEAM(pb + 11);
    LAYER(0, 1)
    LAYER(1, 13)
#undef LAYER
#undef IN
#undef SEAM
}

extern "C" void kernel_launch(void* const* d_in, const int* in_sizes, int n_in, void* d_out, int out_size, void* d_ws, size_t ws_size, hipStream_t stream) {
    static int grid = 0;
    if (grid == 0) {
        if (n_in != N_IN || in_sizes[0] != M * DM || out_size != M * DM || ws_size < WS_END) { fprintf(stderr, "kernel_launch: unexpected shapes (n_in %d, in0 %d, out %d, ws %zu)\n", n_in, n_in > 0 ? in_sizes[0] : -1, out_size, ws_size); grid = -1; return; }
        int dev = 0, cus = 0, per_cu = 0;
        if (hipGetDevice(&dev) != hipSuccess || hipDeviceGetAttribute(&cus, hipDeviceAttributeMultiprocessorCount, dev) != hipSuccess) { grid = -1; return; }
        if (hipFuncSetAttribute((const void*)mega_fwd, hipFuncAttributeMaxDynamicSharedMemorySize, LDS_BYTES) != hipSuccess) { fprintf(stderr, "kernel_launch: hipFuncSetAttribute failed\n"); grid = -1; return; }
        if (hipOccupancyMaxActiveBlocksPerMultiprocessor(&per_cu, (const void*)mega_fwd, NWAVES * 64, LDS_BYTES) != hipSuccess || per_cu < 1) { fprintf(stderr, "kernel_launch: occupancy query says %d blocks per CU\n", per_cu); (void)hipGetLastError(); grid = -1; return; }
        grid = cus;
    }
    if (grid < 0) return;
    (void)hipMemsetAsync((char*)d_ws + WS_CTL, 0, CTL_ZERO_BYTES, stream);
    Args a{};
    for (int i = 0; i < N_IN; ++i) a.in[i] = (const float*)d_in[i];
    a.out = (float*)d_out; a.ws = (unsigned char*)d_ws;
#if MK_ONE_LAUNCH
    a.ph_lo = 0; a.ph_hi = N_PHASES;
    void* kargs[] = {&a};
    hipError_t e = hipLaunchCooperativeKernel((const void*)mega_fwd, dim3(grid), dim3(NWAVES * 64), kargs, LDS_BYTES, stream);
    if (e != hipSuccess) fprintf(stderr, "kernel_launch: cooperative launch failed: %s (grid %d)\n", hipGetErrorString(e), grid);
#else
    for (int p = 0; p < N_PHASES; ++p) { a.ph_lo = p; a.ph_hi = p + 1; hipLaunchKernelGGL(mega_fwd, dim3(grid), dim3(NWAVES * 64), LDS_BYTES, stream, a); }
#endif
}
```
